# Optimizing an MI355X kernel written in HIP

```python
import jax, jax.numpy as jnp
from jax import lax
import numpy as np

D_MODEL = 2048
BATCH = 4
SEQ = 4096
DEPTH = 1

ATTN_HEADS = 16
ATTN_HEAD_DIM = 128
ATTN_WIDTH = ATTN_HEADS * ATTN_HEAD_DIM
DILATED_PATTERNS = ((128, 1), (512, 4), (2048, 16))
BAND_BLOCK = 128
MLSTM_HEADS = 8
MLSTM_QK_DIM = 128
MLSTM_V_DIM = 256
MLSTM_QK_WIDTH = MLSTM_HEADS * MLSTM_QK_DIM
MLSTM_V_WIDTH = MLSTM_HEADS * MLSTM_V_DIM
MLSTM_CHUNK = 64
CONV_WIDTH = 4
NORM_EPS = 1e-6

IN_SPLIT_SIZES = (
    ATTN_WIDTH, ATTN_WIDTH, ATTN_WIDTH,
    ATTN_WIDTH,
    2 * MLSTM_QK_WIDTH,
    MLSTM_V_WIDTH,
    MLSTM_HEADS, MLSTM_HEADS,
    MLSTM_V_WIDTH,
    MLSTM_V_WIDTH,
    D_MODEL, D_MODEL,
)
IN_WIDTH = int(sum(IN_SPLIT_SIZES))
IN_SPLIT_POINTS = [int(v) for v in np.cumsum(IN_SPLIT_SIZES)[:-1]]

kernel_name = "hybrid_dilated_attn_mlstm_gated_block"


def _rmsnorm(x, g):
    xf = x.astype(jnp.float32)
    y = xf * lax.rsqrt(jnp.mean(xf * xf, axis=-1, keepdims=True) + NORM_EPS)
    return (y * g.astype(jnp.float32)).astype(x.dtype)


def _causal_conv_silu(u, w, b):
    k_taps = w.shape[0]
    s = u.shape[1]
    up = jnp.pad(u, ((0, 0), (k_taps - 1, 0), (0, 0)))
    y = b
    for j in range(k_taps):
        y = y + up[:, j:j + s] * w[j]
    return jax.nn.silu(y)


def _dilated_band(q, k, v, slopes, window, dilation):
    bsz, s, h, dh = q.shape
    n_back = window // dilation
    span = dilation * BAND_BLOCK
    s_pad = -(-s // span) * span
    n_blk = s_pad // span
    length = s_pad // dilation

    def phase(a):
        a = jnp.pad(a, ((0, 0), (0, s_pad - s), (0, 0), (0, 0)))
        a = a.reshape(bsz, length, dilation, h, dh).transpose(0, 2, 1, 3, 4)
        return a.reshape(bsz, dilation, n_blk, BAND_BLOCK, h, dh)

    def with_prev(a):
        prev = jnp.pad(a, ((0, 0), (0, 0), (1, 0), (0, 0), (0, 0), (0, 0)))[:, :, :-1]
        return jnp.concatenate([prev, a], axis=3)

    qb = phase(q)
    kk = with_prev(phase(k))
    vv = with_prev(phase(v))
    scores = jnp.einsum('brnqhd,brnkhd->brnhqk', qb, kk,
                        preferred_element_type=jnp.float32)
    qi = jnp.arange(BAND_BLOCK)
    ki = jnp.arange(2 * BAND_BLOCK)
    dist = BAND_BLOCK + qi[:, None] - ki[None, :]
    key_pos = (jnp.arange(n_blk)[:, None] - 1) * BAND_BLOCK + ki[None, :]
    valid = (dist >= 0)[None] & (dist <= n_back)[None] & (key_pos >= 0)[:, None, :]
    alibi = -slopes[:, None, None] * (dist * dilation).astype(jnp.float32)[None]
    scores = jnp.where(valid[None, None, :, None], scores + alibi, -jnp.inf)
    mx = jnp.max(scores, axis=-1)
    p = jnp.exp(scores - mx[..., None])
    den = jnp.sum(p, axis=-1)
    num = jnp.einsum('brnhqk,brnkhd->brnqhd', p, vv.astype(jnp.float32))

    num = num.reshape(bsz, dilation, length, h, dh).transpose(0, 2, 1, 3, 4)
    num = num.reshape(bsz, s_pad, h, dh)[:, :s]

    def unphase_stat(a):
        a = a.transpose(0, 1, 2, 4, 3).reshape(bsz, dilation, length, h)
        return a.transpose(0, 2, 1, 3).reshape(bsz, s_pad, h)[:, :s]

    return num, unphase_stat(den), unphase_stat(mx)


def _dilated_attention(q, k, v):
    q = q * (ATTN_HEAD_DIM ** -0.5)
    slopes = jnp.exp2(-8.0 * jnp.arange(1, ATTN_HEADS + 1, dtype=jnp.float32) / ATTN_HEADS)
    nums, dens, mxs = [], [], []
    for window, dilation in DILATED_PATTERNS:
        n_, d_, m_ = _dilated_band(q, k, v, slopes, window, dilation)
        nums.append(n_); dens.append(d_); mxs.append(m_)
    m_all = jnp.max(jnp.stack(mxs, 0), axis=0)
    wts = [jnp.exp(m_ - m_all) for m_ in mxs]
    num = sum(w_[..., None] * n_ for w_, n_ in zip(wts, nums))
    den = sum(w_ * d_ for w_, d_ in zip(wts, dens))
    return num / den[..., None]


def _mlstm_chunkwise(q, k, v, ig, lf):
    bsz, s, h, dk = q.shape
    dv = v.shape[-1]
    nc = s // MLSTM_CHUNK
    L = MLSTM_CHUNK

    def chunks(a):
        a = a.reshape((bsz, nc, L, h) + a.shape[3:])
        perm = (1, 0, 3, 2) + tuple(range(4, a.ndim))
        return a.transpose(perm)

    xs = (chunks(q), chunks(k * (dk ** -0.5)), chunks(v), chunks(ig), chunks(lf))
    causal = jnp.tril(jnp.ones((L, L), dtype=bool))

    def step(carry, inp):
        c_st, n_st, m_st = carry
        qc, kc, vc, igc, lfc = inp
        b = jnp.cumsum(lfc, axis=-1)
        a = b + m_st[..., None]
        dmat = b[..., :, None] - b[..., None, :] + igc[..., None, :]
        dmat = jnp.where(causal, dmat, -jnp.inf)
        m_t = jnp.maximum(a, jnp.max(dmat, axis=-1))
        w_intra = jnp.exp(dmat - m_t[..., None])
        w_inter = jnp.exp(a - m_t)
        sc = jnp.einsum('bhtd,bhsd->bhts', qc, kc) * w_intra
        num = (w_inter[..., None] * jnp.einsum('bhtd,bhde->bhte', qc, c_st)
               + jnp.einsum('bhts,bhse->bhte', sc, vc))
        den = w_inter * jnp.einsum('bhtd,bhd->bht', qc, n_st) + jnp.sum(sc, axis=-1)
        h_out = num / jnp.maximum(jnp.abs(den), jnp.exp(-m_t))[..., None]
        b_last = b[..., -1]
        g = b_last[..., None] - b + igc
        m_new = jnp.maximum(b_last + m_st, jnp.max(g, axis=-1))
        w_old = jnp.exp(b_last + m_st - m_new)
        w_s = jnp.exp(g - m_new[..., None])
        c_new = w_old[..., None, None] * c_st + jnp.einsum('bhs,bhsd,bhse->bhde', w_s, kc, vc)
        n_new = w_old[..., None] * n_st + jnp.einsum('bhs,bhsd->bhd', w_s, kc)
        return (c_new, n_new, m_new), h_out

    init = (jnp.zeros((bsz, h, dk, dv), jnp.float32),
            jnp.zeros((bsz, h, dk), jnp.float32),
            jnp.zeros((bsz, h), jnp.float32))
    _, hs = lax.scan(step, init, xs)
    return hs.transpose(1, 0, 3, 2, 4).reshape(bsz, s, h, dv)


def setup_inputs(seed: int = 0) -> dict:
    key = jax.random.key(seed)
    ks = jax.random.split(key, 14)
    f32 = jnp.float32
    x = jax.random.normal(ks[0], (BATCH, SEQ, D_MODEL), f32)
    norm_g = 1.0 + 0.02 * jax.random.normal(ks[1], (D_MODEL,), f32)
    w_in = jax.random.normal(ks[2], (D_MODEL, IN_WIDTH), f32) * D_MODEL ** -0.5
    b_i = 0.1 * jax.random.normal(ks[3], (MLSTM_HEADS,), f32)
    b_f = jnp.linspace(3.0, 6.0, MLSTM_HEADS, dtype=f32) + 0.1 * jax.random.normal(ks[4], (MLSTM_HEADS,), f32)
    b_if = jnp.concatenate([b_i, b_f])
    conv_w = jax.random.normal(ks[5], (CONV_WIDTH, 2 * MLSTM_QK_WIDTH), f32) * CONV_WIDTH ** -0.5
    conv_b = 0.02 * jax.random.normal(ks[6], (2 * MLSTM_QK_WIDTH,), f32)
    mlstm_norm_g = 1.0 + 0.02 * jax.random.normal(ks[7], (MLSTM_V_WIDTH,), f32)
    w_attn_branch = jax.random.normal(ks[8], (ATTN_WIDTH, D_MODEL), f32) * ATTN_WIDTH ** -0.5
    w_mlstm_branch = jax.random.normal(ks[9], (MLSTM_V_WIDTH, D_MODEL), f32) * MLSTM_V_WIDTH ** -0.5
    w_out = jax.random.normal(ks[10], (D_MODEL, D_MODEL), f32) * D_MODEL ** -0.5
    final_norm_g = 1.0 + 0.02 * jax.random.normal(ks[11], (D_MODEL,), f32)
    return {"x": x, "norm_g": norm_g, "w_in": w_in, "b_if": b_if, "conv_w": conv_w,
            "conv_b": conv_b, "mlstm_norm_g": mlstm_norm_g, "w_attn_branch": w_attn_branch,
            "w_mlstm_branch": w_mlstm_branch, "w_out": w_out, "final_norm_g": final_norm_g}


def reference(x, norm_g, w_in, b_if, conv_w, conv_b, mlstm_norm_g, w_attn_branch,
              w_mlstm_branch, w_out, final_norm_g):
    bsz, s, _ = x.shape
    f32 = jnp.float32
    for _layer in range(DEPTH):
        hn = _rmsnorm(x, norm_g)
        proj = jnp.einsum('bsd,de->bse', hn, w_in)
        (aq, ak, av, az, mqk, mv, mi, mf, mo, mz, gate_a, gate_m) = jnp.split(
            proj, IN_SPLIT_POINTS, axis=-1)

        heads = lambda t: t.reshape(bsz, s, ATTN_HEADS, ATTN_HEAD_DIM)
        attn = _dilated_attention(heads(aq), heads(ak), heads(av)).reshape(bsz, s, ATTN_WIDTH)
        attn = attn.astype(x.dtype) * jax.nn.silu(az)
        y_a = jnp.einsum('bse,ed->bsd', attn, w_attn_branch)

        qk = _causal_conv_silu(mqk, conv_w, conv_b)
        mq, mk = jnp.split(qk, 2, axis=-1)
        mq = mq.reshape(bsz, s, MLSTM_HEADS, MLSTM_QK_DIM).astype(f32)
        mk = mk.reshape(bsz, s, MLSTM_HEADS, MLSTM_QK_DIM).astype(f32)
        mvh = mv.reshape(bsz, s, MLSTM_HEADS, MLSTM_V_DIM).astype(f32)
        ig = mi.astype(f32) + b_if[:MLSTM_HEADS].astype(f32)
        lf = jax.nn.log_sigmoid(mf.astype(f32) + b_if[MLSTM_HEADS:].astype(f32))
        cell = _mlstm_chunkwise(mq, mk, mvh, ig, lf)
        cell = jax.nn.sigmoid(mo.astype(f32)).reshape(bsz, s, MLSTM_HEADS, MLSTM_V_DIM) * cell
        cell = cell * lax.rsqrt(jnp.mean(cell * cell, axis=-1, keepdims=True) + NORM_EPS)
        cell = cell.reshape(bsz, s, MLSTM_V_WIDTH) * mlstm_norm_g.astype(f32)
        mem = cell.astype(x.dtype) * jax.nn.silu(mz)
        y_m = jnp.einsum('bse,ed->bsd', mem, w_mlstm_branch)

        merged = jax.nn.sigmoid(gate_a) * y_a + jax.nn.sigmoid(gate_m) * y_m
        x = x + jnp.einsum('bsd,de->bse', merged, w_out)
    return _rmsnorm(x, final_norm_g)
```

```cpp
#include <hip/hip_runtime.h>
#include <hip/hip_cooperative_groups.h>
#include <cstdio>
namespace cg = cooperative_groups;
namespace pg8 {
#define PG8_LAS __attribute__((address_space(3)))
typedef unsigned short bf16_t;
typedef short bf16x8 __attribute__((ext_vector_type(8)));
typedef float f32x4 __attribute__((ext_vector_type(4)));
typedef unsigned u32x4 __attribute__((ext_vector_type(4)));
constexpr int BM = 256, BK = 64, HALF = 128, HTB = HALF * BK * 2  , STAGE_BYTES = 8 * HTB, NXCD = 8, WGM = 8;

__host__ __device__ __forceinline__ int lds_byte(int r, int c) { const int st = (r >> 4) * 2 + (c >> 5), rr = r & 15, cc = c & 31, ob = rr * 64 + cc * 2; return st * 1024 + (ob ^ (((ob >> 9) & 1) << 5)); }
__host__ __device__ __forceinline__ void stage_rc(int b, int& R, int& C) { const int st = b / 1024, sb = b % 1024, swz = sb ^ (((sb >> 9) & 1) << 5); R = (st >> 1) * 16 + swz / 64; C = (st & 1) * 32 + (swz % 64) / 2; }
__host__ __device__ __forceinline__ int perm32(int rho) { const int n = rho >> 4, i = rho & 15; return 8 * (i >> 2) + 4 * n + (i & 3); }

struct Unit { int pm, pn; };
struct Gemm { const bf16_t* A; const bf16_t* Bt; int M, N, K; };

struct StaticOrder {
    int nM, nN, nwg, G, c;
    __host__ __device__ void init(int M, int N, int G_, int c_) { nM = M / BM; nN = N / BM; nwg = nM * nN; G = G_; c = c_; }
    __host__ __device__ bool next(int i, Unit& u) const {
        const long L = (long)i * G + c; if (L >= nwg) return false;
        int wgid = (int)L; { const int q = nwg / NXCD, r = nwg % NXCD, xcd = wgid % NXCD, off = wgid / NXCD; wgid = (xcd < r ? xcd * (q + 1) : r * (q + 1) + (xcd - r) * q) + off; }
        const int nig = WGM * nN, gid = wgid / nig, fm = gid * WGM, gsz = (nM - fm) < WGM ? (nM - fm) : WGM;
        u.pm = fm + ((wgid % nig) % gsz); u.pn = (wgid % nig) / gsz; return true;
    }
    __device__ __forceinline__ void a_ready(const Unit&) const {}
    __device__ __forceinline__ void done(const Unit&) const {}
};
__device__ __forceinline__ unsigned cvt_pk_bf16(float lo, float hi) { unsigned r; asm volatile("v_cvt_pk_bf16_f32 %0, %1, %2" : "=v"(r) : "v"(lo), "v"(hi)); return r; }
typedef float f32x2 __attribute__((ext_vector_type(2)));
template <class Epi, class Sched, bool STAMP = false>
__device__ __forceinline__ void gemm_phase(PG8_LAS unsigned char* lds, const Gemm g, const Sched& S, const Epi& E, unsigned long long* stamps, const int tid_in) {
    const int tid = tid_in, wid = __builtin_amdgcn_readfirstlane(tid >> 6), lane = tid & 63, wr = wid >> 2, wc = wid & 3, fr = lane & 15, fq = lane >> 4;
    const int K = g.K, nt = K / BK;
    int ts_lo = 0, ts_hi = 0, nts = 0; const unsigned long long rt_entry = STAMP ? (unsigned long long)wall_clock64() : 0ull;
#define PG8_STAMP() do { if (STAMP && wid == 0 && nts < 64) { const unsigned long long _c = (unsigned long long)clock64(); \
        ts_lo = (lane == nts) ? (int)(unsigned)_c : ts_lo; ts_hi = (lane == nts) ? (int)(unsigned)(_c >> 32) : ts_hi; ++nts; } } while (0)
    PG8_STAMP();
    unsigned voffA[2], voffB[2];
#pragma unroll
    for (int i = 0; i < 2; ++i) { int R, C; stage_rc(tid * 16 + i * 8192, R, C); const int Rb = Epi::PERM ? ((R & ~31) + perm32(R & 31)) : R;
        voffA[i] = (unsigned)(R * K + C) * 2u; voffB[i] = (unsigned)(Rb * K + C) * 2u; }
    const size_t kstep = (size_t)(BK * 2);
    const size_t hstep = (size_t)HALF * K * 2;
    const size_t tstep = 2 * hstep;
    const unsigned ldsw = (unsigned)wid * 1024u;
    const int aoff = lds_byte(wr * 64 + fr, fq * 8), boff = lds_byte(wc * 32 + fr, fq * 8);
#define PG8_SA(b, h) (((b) * 2 + (h)) * HTB)
#define PG8_SB(b, h) ((4 + (b) * 2 + (h)) * HTB)
#define PG8_STAGE(bufoff, gbase, voff) do { _Pragma("unroll") for (int _i = 0; _i < 2; ++_i) \
        __builtin_amdgcn_global_load_lds((const unsigned*)((const char*)(gbase) + (voff)[_i]), (PG8_LAS unsigned*)(lds + (bufoff) + ldsw + _i * 8192), 16, 0, 0); } while (0)
#define PG8_LDA(dst, b, h) do { _Pragma("unroll") for (int m = 0; m < 4; ++m) _Pragma("unroll") for (int k = 0; k < 2; ++k) dst[m][k] = *(const PG8_LAS bf16x8*)(lds + PG8_SA(b, h) + aoff + m * 2048 + k * 1024); } while (0)
#define PG8_LDB(dst, b, h) do { _Pragma("unroll") for (int n = 0; n < 2; ++n) _Pragma("unroll") for (int k = 0; k < 2; ++k) dst[n][k] = *(const PG8_LAS bf16x8*)(lds + PG8_SB(b, h) + boff + n * 2048 + k * 1024); } while (0)
#define PG8_MMA(ai, bj, At, Bt) do { __builtin_amdgcn_s_setprio(1); _Pragma("unroll") for (int m = 0; m < 4; ++m) _Pragma("unroll") for (int n = 0; n < 2; ++n) _Pragma("unroll") for (int k = 0; k < 2; ++k) \
        acc[ai][bj][m][n] = __builtin_amdgcn_mfma_f32_16x16x32_bf16(Bt[n][k], At[m][k], acc[ai][bj][m][n], 0, 0, 0); __builtin_amdgcn_s_setprio(0); } while (0)
#define PG8_WAIT_V(n) asm volatile("s_waitcnt vmcnt(" #n ")" ::: "memory")
#define PG8_WAIT_L(n) asm volatile("s_waitcnt lgkmcnt(" #n ")" ::: "memory")
#define PG8_BAR __builtin_amdgcn_s_barrier()
#define PG8_SCHED __builtin_amdgcn_sched_barrier(0)
    Unit cur, nxt; int ui = 0;
    if (!S.next(0, cur)) return;
    f32x4 acc[2][2][4][2];
#pragma unroll
    for (int a = 0; a < 2; ++a)
#pragma unroll
        for (int b = 0; b < 2; ++b)
#pragma unroll
            for (int m = 0; m < 4; ++m)
#pragma unroll
                for (int n = 0; n < 2; ++n) acc[a][b][m][n] = (f32x4){0.f, 0.f, 0.f, 0.f};
    bf16x8 At[4][2], B0[2][2], B1[2][2];
    const char* cA = (const char*)g.A + (size_t)cur.pm * tstep; const char* cB = (const char*)g.Bt + (size_t)cur.pn * tstep;
    S.a_ready(cur);
    PG8_STAGE(PG8_SB(0, 0), cB, voffB); PG8_STAGE(PG8_SA(0, 0), cA, voffA); PG8_STAGE(PG8_SB(0, 1), cB + hstep, voffB); PG8_STAGE(PG8_SA(0, 1), cA + hstep, voffA);
    if (wr == 1) PG8_BAR;
    PG8_WAIT_V(4); PG8_BAR;
    PG8_STAGE(PG8_SB(1, 0), cB + kstep, voffB); PG8_STAGE(PG8_SA(1, 0), cA + kstep, voffA); PG8_STAGE(PG8_SB(1, 1), cB + hstep + kstep, voffB);
    PG8_WAIT_V(6); PG8_BAR;
    PG8_STAMP();
    for (;;) {
        const bool has_next = S.next(ui + 1, nxt);
        const char* nA = has_next ? (const char*)g.A + (size_t)nxt.pm * tstep : cA; const char* nB = has_next ? (const char*)g.Bt + (size_t)nxt.pn * tstep : cB;
        for (int t = 0; t < nt; t += 2) {
            const bool last = (t == nt - 2);
            const char* a1 = cA + (size_t)(t + 1) * kstep;
            const char* a2 = last ? nA : cA + (size_t)(t + 2) * kstep; const char* b2 = last ? nB : cB + (size_t)(t + 2) * kstep;
            const char* a3 = a2 + kstep; const char* b3 = b2 + kstep;
            if (last && has_next) S.a_ready(nxt);
            PG8_LDB(B0, 0, 0); PG8_SCHED; PG8_LDA(At, 0, 0); PG8_STAGE(PG8_SA(1, 1), a1 + hstep, voffA);
            PG8_WAIT_L(8); PG8_BAR; PG8_WAIT_L(0); PG8_MMA(0, 0, At, B0); PG8_BAR; PG8_SCHED;
            PG8_LDB(B1, 0, 1); PG8_STAGE(PG8_SB(0, 0), b2, voffB);
            PG8_BAR; PG8_WAIT_L(0); PG8_MMA(0, 1, At, B1); PG8_BAR;
            PG8_LDA(At, 0, 1); PG8_STAGE(PG8_SA(0, 0), a2, voffA);
            PG8_BAR; PG8_WAIT_L(0); PG8_MMA(1, 0, At, B0); PG8_BAR; PG8_SCHED;
            PG8_STAGE(PG8_SB(0, 1), b2 + hstep, voffB);
            PG8_WAIT_V(6); PG8_BAR; PG8_MMA(1, 1, At, B1); PG8_BAR;
            PG8_LDB(B0, 1, 0); PG8_SCHED; PG8_LDA(At, 1, 0); PG8_STAGE(PG8_SA(0, 1), a2 + hstep, voffA);
            PG8_WAIT_L(8); PG8_BAR; PG8_WAIT_L(0); PG8_MMA(0, 0, At, B0); PG8_BAR; PG8_SCHED;
            PG8_LDB(B1, 1, 1); PG8_STAGE(PG8_SB(1, 0), b3, voffB);
            PG8_BAR; PG8_WAIT_L(0); PG8_MMA(0, 1, At, B1); PG8_BAR;
            PG8_LDA(At, 1, 1); PG8_STAGE(PG8_SA(1, 0), a3, voffA);
            PG8_BAR; PG8_WAIT_L(0); PG8_MMA(1, 0, At, B0); PG8_BAR; PG8_SCHED;
            PG8_STAGE(PG8_SB(1, 1), b3 + hstep, voffB);
            PG8_WAIT_V(6); PG8_BAR; PG8_MMA(1, 1, At, B1); PG8_BAR;
        }
        PG8_STAMP();
        if constexpr (!Epi::AFTER_DRAIN) { E(acc, cur, wr, wc, fr, fq); S.done(cur); }
        PG8_STAMP();
        if (!has_next) break;
#pragma unroll
        for (int a = 0; a < 2; ++a)
#pragma unroll
            for (int b = 0; b < 2; ++b)
#pragma unroll
                for (int m = 0; m < 4; ++m)
#pragma unroll
                    for (int n = 0; n < 2; ++n) acc[a][b][m][n] = (f32x4){0.f, 0.f, 0.f, 0.f};
        cur = nxt; cA = nA; cB = nB; ++ui;
    }
    PG8_WAIT_V(0);
    if (wr == 0) PG8_BAR;
    PG8_BAR;
    if constexpr (Epi::AFTER_DRAIN) { E.fused(acc, cur, wr, wc, fr, fq, lds, wid, lane); S.done(cur); }
    PG8_STAMP();
    if (STAMP && wid == 0) { stamps[lane] = lane < nts ? (((unsigned long long)(unsigned)ts_hi << 32) | (unsigned)ts_lo) : 0ull;
        if (lane == 62) stamps[62] = rt_entry; if (lane == 63) stamps[63] = (unsigned long long)wall_clock64(); }
#undef PG8_STAMP
#undef PG8_SA
#undef PG8_SB
#undef PG8_STAGE
#undef PG8_LDA
#undef PG8_LDB
#undef PG8_MMA
#undef PG8_WAIT_V
#undef PG8_WAIT_L
#undef PG8_BAR
#undef PG8_SCHED
}
}


using pg8::bf16_t; using pg8::bf16x8; using pg8::f32x4; using pg8::u32x4; using pg8::cvt_pk_bf16;
typedef short s16x4 __attribute__((ext_vector_type(4)));
typedef unsigned u32x2 __attribute__((ext_vector_type(2)));
#define LAS __attribute__((address_space(3)))
#define DI __device__ __forceinline__

constexpr int M_TOK = 16384, DM = 2048, SEQ = 4096, INW = 20496;
constexpr size_t MiB = (size_t)1 << 20;
constexpr size_t WS_WINT = 0, WS_WA = 80 * MiB, WS_WM = 88 * MiB, WS_WO = 96 * MiB, WS_GATES = 104 * MiB, WS_LSE = 105 * MiB, WS_SLOT = 112 * MiB, SLOT = 64 * MiB;
constexpr int LDS_BYTES = 143360;
constexpr int NPHASE = 13;

struct Params {
    const float *x, *norm_g, *w_in, *b_if, *conv_w, *conv_b, *mnorm_g, *w_attn, *w_mlstm, *w_out, *final_g;
    float* out; unsigned char* ws; int ph_lo, ph_hi;
};

struct Ctx { int tid, bid, nb; };
DI float bf_lo(unsigned u) { return __uint_as_float(u << 16); }
DI float bf_hi(unsigned u) { return __uint_as_float(u & 0xffff0000u); }
DI float bf1(bf16_t b) { return __uint_as_float(((unsigned)b) << 16); }
DI bf16_t f2bf(float f) { return (bf16_t)(cvt_pk_bf16(f, 0.f) & 0xffffu); }
DI float sigmoidf_(float z) { return __builtin_amdgcn_rcpf(1.f + __expf(-z)); }
DI float siluf_(float z) { return z * sigmoidf_(z); }
DI float wave_sum(float v) {
#pragma unroll
    for (int o = 1; o < 64; o <<= 1) v += __shfl_xor(v, o);
    return v;
}
DI bf16_t* slot(const Params& p, int i) { return (bf16_t*)(p.ws + WS_SLOT + (size_t)i * SLOT); }
DI f32x4 mfma16(bf16x8 a, bf16x8 b, f32x4 c) { return __builtin_amdgcn_mfma_f32_16x16x32_bf16(a, b, c, 0, 0, 0); }
DI bf16x8 tr8(LAS unsigned char* lo, LAS unsigned char* hi) {
    s16x4 a = __builtin_amdgcn_ds_read_tr16_b64_v4i16((LAS s16x4*)lo);
    s16x4 b = __builtin_amdgcn_ds_read_tr16_b64_v4i16((LAS s16x4*)hi);
    return __builtin_shufflevector(a, b, 0, 1, 2, 3, 4, 5, 6, 7);
}

struct EpiSplitBf16 {
    static constexpr bool PERM = true, AFTER_DRAIN = false;
    bf16_t* O; size_t seg_stride;
    DI void operator()(const f32x4 (&acc)[2][2][4][2], const pg8::Unit& u, int wr, int wc, int fr, int fq) const {
        const int row0 = u.pm * 256 + wr * 64 + fr; int colt = u.pn * 256; const int seg = colt >> 11; colt &= 2047;
        bf16_t* base = O + (size_t)seg * seg_stride; const int col0 = colt + wc * 32 + 8 * fq;
#pragma unroll
        for (int ai = 0; ai < 2; ++ai)
#pragma unroll
            for (int m = 0; m < 4; ++m) { bf16_t* rowp = base + (size_t)(row0 + ai * 128 + m * 16) * DM + col0;
#pragma unroll
                for (int bj = 0; bj < 2; ++bj) { const f32x4 v0 = acc[ai][bj][m][0], v1 = acc[ai][bj][m][1];
                    u32x4 w; w.x = cvt_pk_bf16(v0[0], v0[1]); w.y = cvt_pk_bf16(v0[2], v0[3]); w.z = cvt_pk_bf16(v1[0], v1[1]); w.w = cvt_pk_bf16(v1[2], v1[3]);
                    *(u32x4*)(rowp + bj * 128) = w; } }
    }
};
template <int MODE> struct EpiGate {
    static constexpr bool PERM = true, AFTER_DRAIN = false;
    const bf16_t* gate; float* T; bf16_t* O;
    DI void operator()(const f32x4 (&acc)[2][2][4][2], const pg8::Unit& u, int wr, int wc, int fr, int fq) const {
        const int row0 = u.pm * 256 + wr * 64 + fr, col0 = u.pn * 256 + wc * 32 + 8 * fq;
#pragma unroll
        for (int ai = 0; ai < 2; ++ai)
#pragma unroll
            for (int m = 0; m < 4; ++m) { const size_t ro = (size_t)(row0 + ai * 128 + m * 16) * DM + col0;
#pragma unroll
                for (int bj = 0; bj < 2; ++bj) { const size_t o = ro + bj * 128;
                    const u32x4 gq = *(const u32x4*)(gate + o);
                    f32x4 v0 = acc[ai][bj][m][0], v1 = acc[ai][bj][m][1];
                    v0[0] *= sigmoidf_(bf_lo(gq.x)); v0[1] *= sigmoidf_(bf_hi(gq.x)); v0[2] *= sigmoidf_(bf_lo(gq.y)); v0[3] *= sigmoidf_(bf_hi(gq.y));
                    v1[0] *= sigmoidf_(bf_lo(gq.z)); v1[1] *= sigmoidf_(bf_hi(gq.z)); v1[2] *= sigmoidf_(bf_lo(gq.w)); v1[3] *= sigmoidf_(bf_hi(gq.w));
                    if (MODE == 0) { *(f32x4*)(T + o) = v0; *(f32x4*)(T + o + 4) = v1; }
                    else { v0 += *(const f32x4*)(T + o); v1 += *(const f32x4*)(T + o + 4);
                        u32x4 w; w.x = cvt_pk_bf16(v0[0], v0[1]); w.y = cvt_pk_bf16(v0[2], v0[3]); w.z = cvt_pk_bf16(v1[0], v1[1]); w.w = cvt_pk_bf16(v1[2], v1[3]);
                        *(u32x4*)(O + o) = w; } } }
    }
};
struct EpiResid {
    static constexpr bool PERM = false, AFTER_DRAIN = false;
    const float* x; float* out;
    DI void operator()(const f32x4 (&acc)[2][2][4][2], const pg8::Unit& u, int wr, int wc, int fr, int fq) const {
        const int row0 = u.pm * 256 + wr * 64 + fr, col0 = u.pn * 256 + wc * 32 + 4 * fq;
#pragma unroll
        for (int ai = 0; ai < 2; ++ai)
#pragma unroll
            for (int m = 0; m < 4; ++m) { const size_t ro = (size_t)(row0 + ai * 128 + m * 16) * DM + col0;
#pragma unroll
                for (int bj = 0; bj < 2; ++bj)
#pragma unroll
                    for (int n = 0; n < 2; ++n) { const size_t o = ro + bj * 128 + n * 16; *(f32x4*)(out + o) = acc[ai][bj][m][n] + *(const f32x4*)(x + o); } }
    }
};
template <class Epi> DI void run_gemm(const Ctx cx, LAS unsigned char* lds, const bf16_t* A, const bf16_t* Bt, int N, int K, const Epi& E) {
    pg8::Gemm g; g.A = A; g.Bt = Bt; g.M = M_TOK; g.N = N; g.K = K;
    pg8::StaticOrder S; S.init(M_TOK, N, cx.nb, cx.bid);
    pg8::gemm_phase<Epi, pg8::StaticOrder, false>(lds, g, S, E, nullptr, cx.tid);
}

DI void transpose_item(const float* W, int ldw, int sc0, bf16_t* WT, int dr0, int kb, LAS float* scr, int lane) {
    const int k0 = 64 * kb;
#pragma unroll 8
    for (int i = 0; i < 32; ++i) { const int kk = 2 * i + (lane >> 5); scr[kk * 33 + (lane & 31)] = W[(size_t)(k0 + kk) * ldw + sc0 + (lane & 31)]; }
    asm volatile("s_waitcnt lgkmcnt(0)" ::: "memory");
    const int c = lane & 7;
#pragma unroll
    for (int j = 0; j < 4; ++j) { const int n = (lane >> 3) + 8 * j; const LAS float* s = scr + (8 * c) * 33 + n;
        u32x4 o; o.x = cvt_pk_bf16(s[0 * 33], s[1 * 33]); o.y = cvt_pk_bf16(s[2 * 33], s[3 * 33]); o.z = cvt_pk_bf16(s[4 * 33], s[5 * 33]); o.w = cvt_pk_bf16(s[6 * 33], s[7 * 33]);
        *(u32x4*)(WT + (size_t)(dr0 + n) * DM + k0 + 8 * c) = o; }
    asm volatile("s_waitcnt lgkmcnt(0)" ::: "memory");
}
DI void ph_prep(const Ctx cx, const Params& p, LAS unsigned char* lds) {
    const int tid = cx.tid, wave = tid >> 6, lane = tid & 63;
    const int gw = cx.bid * 8 + wave, NGW = cx.nb * 8;
    bf16_t* hn = (bf16_t*)p.out;
    float* ig = (float*)(p.ws + WS_GATES); float* lf = ig + M_TOK * 8;
    for (int row = gw; row < M_TOK; row += NGW) {
        const f32x4* xr = (const f32x4*)(p.x + (size_t)row * DM) + lane;
        f32x4 v[8]; float s = 0.f;
#pragma unroll
        for (int j = 0; j < 8; ++j) { v[j] = xr[64 * j]; s += (v[j].x * v[j].x + v[j].y * v[j].y) + (v[j].z * v[j].z + v[j].w * v[j].w); }
        s = wave_sum(s);
        const float rstd = rsqrtf(s * (1.f / DM) + 1e-6f);
        float acc[16];
#pragma unroll
        for (int c = 0; c < 16; ++c) acc[c] = 0.f;
#pragma unroll
        for (int j = 0; j < 8; ++j) {
            const f32x4 g4 = ((const f32x4*)p.norm_g)[64 * j + lane];
            const f32x4 hv = (v[j] * rstd) * g4;
            u32x2 pk; pk.x = cvt_pk_bf16(hv.x, hv.y); pk.y = cvt_pk_bf16(hv.z, hv.w);
            *(u32x2*)(hn + (size_t)row * DM + 256 * j + 4 * lane) = pk;
#pragma unroll
            for (int e = 0; e < 4; ++e) {
                const f32x4* wp = (const f32x4*)(p.w_in + (size_t)(256 * j + 4 * lane + e) * INW + 12288);
                const f32x4 w0 = wp[0], w1 = wp[1], w2 = wp[2], w3 = wp[3]; const float hh = hv[e];
                acc[0] += hh * w0.x; acc[1] += hh * w0.y; acc[2] += hh * w0.z; acc[3] += hh * w0.w;
                acc[4] += hh * w1.x; acc[5] += hh * w1.y; acc[6] += hh * w1.z; acc[7] += hh * w1.w;
                acc[8] += hh * w2.x; acc[9] += hh * w2.y; acc[10] += hh * w2.z; acc[11] += hh * w2.w;
                acc[12] += hh * w3.x; acc[13] += hh * w3.y; acc[14] += hh * w3.z; acc[15] += hh * w3.w;
            }
        }
        float mine = 0.f;
#pragma unroll
        for (int c = 0; c < 16; ++c) { const float t = wave_sum(acc[c]); mine = (lane == c) ? t : mine; }
        if (lane < 16) { const float z = mine + p.b_if[lane];
            if (lane < 8) ig[(size_t)row * 8 + lane] = z; else lf[(size_t)row * 8 + lane - 8] = fminf(z, 0.f) - log1pf(__expf(-fabsf(z))); }
    }
    LAS float* scr = (LAS float*)(lds + wave * 8448);
    constexpr int I_IN = 32 * 640, I_SQ = 32 * 64, NIT = I_IN + 3 * I_SQ;
    for (int it = gw; it < NIT; it += NGW) {
        if (it < I_IN) { const int kb = it / 640, nb = it % 640, n0 = 32 * nb;
            transpose_item(p.w_in, INW, n0 < 12288 ? n0 : n0 + 16, (bf16_t*)(p.ws + WS_WINT), n0, kb, scr, lane); }
        else { int r = it - I_IN; const int which = r / I_SQ; r -= which * I_SQ; const int kb = r >> 6, nb = r & 63;
            const float* W = which == 0 ? p.w_attn : (which == 1 ? p.w_mlstm : p.w_out);
            bf16_t* WT = (bf16_t*)(p.ws + (which == 0 ? WS_WA : (which == 1 ? WS_WM : WS_WO)));
            transpose_item(W, DM, 32 * nb, WT, 32 * nb, kb, scr, lane); }
    }
}

DI void ph_attn(const Ctx cx, const Params& p, LAS unsigned char* lds) {
    const bf16_t* Qg = slot(p, 0); const bf16_t* Kg = slot(p, 1); const bf16_t* Vg = slot(p, 2);
    float* lse = (float*)(p.ws + WS_LSE);
    const int tid = cx.tid, wave = tid >> 6, lane = tid & 63, fr = lane & 15, g = lane >> 4, q4 = fr >> 2, p4 = fr & 3;
    constexpr int RS = 272, PS = 336;
    LAS unsigned char* Ks = lds; LAS unsigned char* Vs = lds + 256 * RS;
    LAS unsigned char* Pw = lds + wave * 5376;
    const int i0 = wave * 16, w0 = i0 < 96 ? i0 : 96;
    for (int it = cx.bid; it < 6144; it += cx.nb) {
        const int blk = it & 31, rest = it >> 5, pat = rest % 3, bh = rest / 3, h = bh & 15, b = bh >> 4;
        const int sh = 2 * pat, r = 1 << sh, nblk = 32 >> sh, php = blk >> (5 - sh), n = blk & (nblk - 1);
        const size_t tok0 = (size_t)b * SEQ;
        bf16_t* Og = slot(p, 4 + pat);
        __syncthreads();
#pragma unroll
        for (int i = 0; i < 8; ++i) { const int idx = tid + 512 * i, row = idx >> 4, ch = idx & 15; int uu = (n - 1) * 128 + row; uu = uu < 0 ? 0 : uu;
            const size_t go = (tok0 + (size_t)uu * r + php) * DM + h * 128 + ch * 8;
            const u32x4 kv = *(const u32x4*)(Kg + go); const u32x4 vv = *(const u32x4*)(Vg + go);
            *(LAS u32x4*)(Ks + row * RS + ch * 16) = kv; *(LAS u32x4*)(Vs + row * RS + ch * 16) = vv; }
        bf16x8 qf[4];
        { const size_t tq = tok0 + (size_t)(n * 128 + i0 + fr) * r + php; const bf16_t* qp = Qg + tq * DM + h * 128 + 8 * g;
#pragma unroll
          for (int ks = 0; ks < 4; ++ks) qf[ks] = *(const bf16x8*)(qp + 32 * ks); }
        __syncthreads();
        f32x4 sacc[10];
#pragma unroll
        for (int kt = 0; kt < 10; ++kt) { sacc[kt] = (f32x4){0.f, 0.f, 0.f, 0.f};
#pragma unroll
            for (int ks = 0; ks < 4; ++ks) { const bf16x8 kf = *(const LAS bf16x8*)(Ks + (w0 + 16 * kt + fr) * RS + (32 * ks + 8 * g) * 2); sacc[kt] = mfma16(qf[ks], kf, sacc[kt]); } }
        const float scale = 0.08838834764831845f, sl = exp2f(-0.5f * (float)(h + 1)) * (float)r;
        float mx[4] = {-INFINITY, -INFINITY, -INFINITY, -INFINITY};
#pragma unroll
        for (int kt = 0; kt < 10; ++kt) { const int j = w0 + 16 * kt + fr;
#pragma unroll
            for (int jj = 0; jj < 4; ++jj) { const int dist = 128 + i0 + 4 * g + jj - j; const bool ok = dist >= 0 && dist <= 128 && (n > 0 || j >= 128);
                const float sv = ok ? sacc[kt][jj] * scale - sl * (float)dist : -INFINITY; sacc[kt][jj] = sv; mx[jj] = fmaxf(mx[jj], sv); } }
#pragma unroll
        for (int jj = 0; jj < 4; ++jj) {
#pragma unroll
            for (int o = 1; o < 16; o <<= 1) mx[jj] = fmaxf(mx[jj], __shfl_xor(mx[jj], o)); }
        __syncthreads();
        float den[4] = {0.f, 0.f, 0.f, 0.f};
#pragma unroll
        for (int kt = 0; kt < 10; ++kt)
#pragma unroll
            for (int jj = 0; jj < 4; ++jj) { const float pe = __expf(sacc[kt][jj] - mx[jj]); den[jj] += pe; *(LAS bf16_t*)(Pw + (4 * g + jj) * PS + (16 * kt + fr) * 2) = f2bf(pe); }
#pragma unroll
        for (int jj = 0; jj < 4; ++jj) {
#pragma unroll
            for (int o = 1; o < 16; o <<= 1) den[jj] += __shfl_xor(den[jj], o); }
        asm volatile("s_waitcnt lgkmcnt(0)" ::: "memory");
        f32x4 oacc[8];
#pragma unroll
        for (int dt = 0; dt < 8; ++dt) oacc[dt] = (f32x4){0.f, 0.f, 0.f, 0.f};
#pragma unroll
        for (int ks = 0; ks < 5; ++ks) { const bf16x8 pf = *(const LAS bf16x8*)(Pw + fr * PS + (32 * ks + 8 * g) * 2);
            LAS unsigned char* vb = Vs + (w0 + 32 * ks + 8 * g + q4) * RS + 8 * p4;
#pragma unroll
            for (int dt = 0; dt < 8; ++dt) { const bf16x8 vf = tr8(vb + 32 * dt, vb + 32 * dt + 4 * RS); oacc[dt] = mfma16(pf, vf, oacc[dt]); } }
        asm volatile("s_waitcnt lgkmcnt(0)" ::: "memory");
        float inv[4];
#pragma unroll
        for (int jj = 0; jj < 4; ++jj) inv[jj] = 1.f / den[jj];
#pragma unroll
        for (int dt = 0; dt < 8; ++dt)
#pragma unroll
            for (int jj = 0; jj < 4; ++jj) *(LAS bf16_t*)(Pw + (4 * g + jj) * RS + (16 * dt + fr) * 2) = f2bf(oacc[dt][jj] * inv[jj]);
        asm volatile("s_waitcnt lgkmcnt(0)" ::: "memory");
#pragma unroll
        for (int i = 0; i < 4; ++i) { const int idx = lane + 64 * i, row = idx >> 4, ch = idx & 15;
            const u32x4 ov = *(const LAS u32x4*)(Pw + row * RS + ch * 16);
            const size_t tq = tok0 + (size_t)(n * 128 + i0 + row) * r + php;
            *(u32x4*)(Og + tq * DM + h * 128 + ch * 8) = ov; }
        if (fr == 0) {
#pragma unroll
            for (int jj = 0; jj < 4; ++jj) { const size_t tq = tok0 + (size_t)(n * 128 + i0 + 4 * g + jj) * r + php;
                lse[(size_t)pat * M_TOK * 16 + tq * 16 + h] = mx[jj] + __logf(den[jj]); } }
    }
}

DI void ph_comb(const Ctx cx, const Params& p) {
    const bf16_t* O0 = slot(p, 4); const bf16_t* O1 = slot(p, 5); const bf16_t* O2 = slot(p, 6); const bf16_t* Z = slot(p, 3);
    bf16_t* AG = slot(p, 7);
    const float* lse = (const float*)(p.ws + WS_LSE);
    const size_t nth = (size_t)cx.nb * 512;
    for (size_t idx = (size_t)cx.bid * 512 + cx.tid; idx < (size_t)M_TOK * 256; idx += nth) {
        const size_t m = idx >> 8; const int c8 = (int)(idx & 255), h = c8 >> 4;
        const float l0 = lse[m * 16 + h], l1 = lse[(size_t)M_TOK * 16 + m * 16 + h], l2 = lse[(size_t)2 * M_TOK * 16 + m * 16 + h];
        const float mxl = fmaxf(l0, fmaxf(l1, l2));
        float w0 = __expf(l0 - mxl), w1 = __expf(l1 - mxl), w2 = __expf(l2 - mxl);
        const float inv = 1.f / (w0 + w1 + w2); w0 *= inv; w1 *= inv; w2 *= inv;
        const size_t o = m * DM + c8 * 8;
        const u32x4 a0 = *(const u32x4*)(O0 + o), a1 = *(const u32x4*)(O1 + o), a2 = *(const u32x4*)(O2 + o), z = *(const u32x4*)(Z + o);
        u32x4 res;
#pragma unroll
        for (int e = 0; e < 4; ++e) {
            const float lo = (w0 * bf_lo(a0[e]) + w1 * bf_lo(a1[e]) + w2 * bf_lo(a2[e])) * siluf_(bf_lo(z[e]));
            const float hi = (w0 * bf_hi(a0[e]) + w1 * bf_hi(a1[e]) + w2 * bf_hi(a2[e])) * siluf_(bf_hi(z[e]));
            res[e] = cvt_pk_bf16(lo, hi); }
        *(u32x4*)(AG + o) = res;
    }
}

DI void ph_conv(const Ctx cx, const Params& p) {
    const bf16_t* U = slot(p, 0); bf16_t* QK = slot(p, 4);
    const size_t nth = (size_t)cx.nb * 512;
    for (size_t idx = (size_t)cx.bid * 512 + cx.tid; idx < (size_t)(M_TOK / 8) * 256; idx += nth) {
        const int c8 = (int)(idx & 255); const size_t t0 = (idx >> 8) * 8; const bool first = (t0 & (SEQ - 1)) == 0;
        float w[4][8], bias[8];
#pragma unroll
        for (int j = 0; j < 4; ++j) { const f32x4 a = *(const f32x4*)(p.conv_w + j * DM + c8 * 8), b2 = *(const f32x4*)(p.conv_w + j * DM + c8 * 8 + 4);
            w[j][0] = a.x; w[j][1] = a.y; w[j][2] = a.z; w[j][3] = a.w; w[j][4] = b2.x; w[j][5] = b2.y; w[j][6] = b2.z; w[j][7] = b2.w; }
        { const f32x4 a = *(const f32x4*)(p.conv_b + c8 * 8), b2 = *(const f32x4*)(p.conv_b + c8 * 8 + 4);
          bias[0] = a.x; bias[1] = a.y; bias[2] = a.z; bias[3] = a.w; bias[4] = b2.x; bias[5] = b2.y; bias[6] = b2.z; bias[7] = b2.w; }
        float u[11][8];
#pragma unroll
        for (int t = 0; t < 11; ++t) { u32x4 raw = (u32x4){0u, 0u, 0u, 0u};
            if (t >= 3 || !first) raw = *(const u32x4*)(U + (t0 + t - 3) * DM + c8 * 8);
#pragma unroll
            for (int e = 0; e < 4; ++e) { u[t][2 * e] = bf_lo(raw[e]); u[t][2 * e + 1] = bf_hi(raw[e]); } }
        const float osc = c8 >= 128 ? 0.08838834764831845f : 1.f;
#pragma unroll
        for (int t = 0; t < 8; ++t) { float y[8];
#pragma unroll
            for (int e = 0; e < 8; ++e) { float a = bias[e];
#pragma unroll
                for (int j = 0; j < 4; ++j) a += w[j][e] * u[t + j][e];
                y[e] = siluf_(a) * osc; }
            u32x4 res; res.x = cvt_pk_bf16(y[0], y[1]); res.y = cvt_pk_bf16(y[2], y[3]); res.z = cvt_pk_bf16(y[4], y[5]); res.w = cvt_pk_bf16(y[6], y[7]);
            *(u32x4*)(QK + (t0 + t) * DM + c8 * 8) = res; }
    }
}

DI void ph_mlstm(const Ctx cx, const Params& p, LAS unsigned char* lds) {
    const bf16_t* QK = slot(p, 4); const bf16_t* Vg = slot(p, 1); bf16_t* Hb = slot(p, 5);
    const float* igp = (const float*)(p.ws + WS_GATES); const float* lfp = igp + M_TOK * 8;
    const int tid = cx.tid, wave = tid >> 6, lane = tid & 63, fr = lane & 15, g = lane >> 4, q4 = fr >> 2, p4 = fr & 3;
    constexpr int RS = 272, VS = 112, SS = 144;
    LAS unsigned char* qs = lds; LAS unsigned char* ks = lds + 17408; LAS unsigned char* vs = lds + 34816; LAS unsigned char* scs = lds + 41984;
    LAS unsigned char* cbs = lds + 51200; LAS float* garr = (LAS float*)(lds + 64256);
    const int tt = wave >> 1, wb = wave & 1;
    for (int item = cx.bid; item < 256; item += cx.nb) {
        const int b = item >> 6, h = (item >> 3) & 7, dvs = item & 7;
        const size_t tok0 = (size_t)b * SEQ;
        __syncthreads();
        for (int i = tid; i < 816; i += 512) *(LAS u32x4*)(cbs + i * 16) = (u32x4){0u, 0u, 0u, 0u};
        if (tid < 128) { const int row = tid >> 1, hf = tid & 1; *(LAS u32x4*)(vs + row * VS + 64 + hf * 16) = hf ? (u32x4){0u, 0u, 0u, 0u} : (u32x4){0x3F80u, 0u, 0u, 0u}; }
        f32x4 C[3];
#pragma unroll
        for (int ct = 0; ct < 3; ++ct) C[ct] = (f32x4){0.f, 0.f, 0.f, 0.f};
        float m_st = 0.f;
        u32x4 pq[2], pk[2], pv; float pig = 0.f, plf = 0.f;
        const int prow = tid >> 4, pch = tid & 15;
#define ML_PREFETCH(cc) do { const size_t tb = tok0 + (size_t)(cc) * 64; \
            pq[0] = *(const u32x4*)(QK + (tb + prow) * DM + h * 128 + pch * 8); pq[1] = *(const u32x4*)(QK + (tb + prow + 32) * DM + h * 128 + pch * 8); \
            pk[0] = *(const u32x4*)(QK + (tb + prow) * DM + 1024 + h * 128 + pch * 8); pk[1] = *(const u32x4*)(QK + (tb + prow + 32) * DM + 1024 + h * 128 + pch * 8); \
            if (tid < 256) pv = *(const u32x4*)(Vg + (tb + (tid >> 2)) * DM + h * 256 + dvs * 32 + (tid & 3) * 8); \
            if (wave == 0) { pig = igp[(tb + lane) * 8 + h]; plf = lfp[(tb + lane) * 8 + h]; } } while (0)
        ML_PREFETCH(0);
        for (int c = 0; c < 64; ++c) {
            *(LAS u32x4*)(qs + prow * RS + pch * 16) = pq[0]; *(LAS u32x4*)(qs + (prow + 32) * RS + pch * 16) = pq[1];
            *(LAS u32x4*)(ks + prow * RS + pch * 16) = pk[0]; *(LAS u32x4*)(ks + (prow + 32) * RS + pch * 16) = pk[1];
            if (tid < 256) *(LAS u32x4*)(vs + (tid >> 2) * VS + (tid & 3) * 16) = pv;
            if (wave == 0) {
                float bcs = plf;
#pragma unroll
                for (int o = 1; o < 64; o <<= 1) { const float t = __shfl_up(bcs, o); if (lane >= o) bcs += t; }
                const float uu = pig - bcs; float cmx = uu;
#pragma unroll
                for (int o = 1; o < 64; o <<= 1) { const float t = __shfl_up(cmx, o); if (lane >= o) cmx = fmaxf(cmx, t); }
                const float cm = fmaxf(m_st, cmx), mt = bcs + cm;
                garr[lane] = uu; garr[64 + lane] = cm; garr[128 + lane] = __expf(m_st - cm); garr[192 + lane] = __expf(-mt);
                const float b_last = __shfl(bcs, 63), cm63 = __shfl(cm, 63);
                if (lane == 0) { garr[256] = cm63; garr[257] = __expf(m_st - cm63); }
                m_st = b_last + cm63;
            }
            __syncthreads();
            if (c + 1 < 64) ML_PREFETCH(c + 1);
            bf16x8 qf[4];
#pragma unroll
            for (int ksn = 0; ksn < 4; ++ksn) qf[ksn] = *(const LAS bf16x8*)(qs + (16 * tt + fr) * RS + (32 * ksn + 8 * g) * 2);
#pragma unroll
            for (int s2 = 0; s2 < 2; ++s2) { const int st = 2 * wb + s2;
                f32x4 sa = (f32x4){0.f, 0.f, 0.f, 0.f};
                if (st <= tt) {
#pragma unroll
                    for (int ksn = 0; ksn < 4; ++ksn) { const bf16x8 kf = *(const LAS bf16x8*)(ks + (16 * st + fr) * RS + (32 * ksn + 8 * g) * 2); sa = mfma16(qf[ksn], kf, sa); } }
                const int sidx = 16 * st + fr; const float us = garr[sidx];
#pragma unroll
                for (int jj = 0; jj < 4; ++jj) { const int t = 16 * tt + 4 * g + jj; const float wi = (sidx <= t) ? __expf(us - garr[64 + t]) : 0.f;
                    *(LAS bf16_t*)(scs + t * SS + sidx * 2) = f2bf(sa[jj] * wi); } }
            __syncthreads();
            {
                f32x4 ai0 = (f32x4){0.f, 0.f, 0.f, 0.f}, ai2 = ai0, as0 = ai0, as2 = ai0;
#pragma unroll
                for (int ksn = 0; ksn < 4; ++ksn) {
                    const bf16x8 c0 = *(const LAS bf16x8*)(cbs + (16 * wb + fr) * RS + (32 * ksn + 8 * g) * 2);
                    const bf16x8 c2 = *(const LAS bf16x8*)(cbs + (32 + fr) * RS + (32 * ksn + 8 * g) * 2);
                    ai0 = mfma16(qf[ksn], c0, ai0); ai2 = mfma16(qf[ksn], c2, ai2); }
#pragma unroll
                for (int ksn = 0; ksn < 2; ++ksn) {
                    const bf16x8 sf = *(const LAS bf16x8*)(scs + (16 * tt + fr) * SS + (32 * ksn + 8 * g) * 2);
                    LAS unsigned char* vb = vs + (32 * ksn + 8 * g + q4) * VS + 8 * p4;
                    const bf16x8 v0 = tr8(vb + 32 * wb, vb + 32 * wb + 4 * VS);
                    const bf16x8 v2 = tr8(vb + 64, vb + 64 + 4 * VS);
                    as0 = mfma16(sf, v0, as0); as2 = mfma16(sf, v2, as2); }
#pragma unroll
                for (int jj = 0; jj < 4; ++jj) { const int t = 16 * tt + 4 * g + jj; const float wi = garr[128 + t];
                    const float num = wi * ai0[jj] + as0[jj]; float dn = wi * ai2[jj] + as2[jj];
                    dn = __shfl(dn, lane & 48);
                    const float hv = num / fmaxf(fabsf(dn), garr[192 + t]);
                    Hb[(tok0 + (size_t)c * 64 + t) * DM + h * 256 + dvs * 32 + 16 * wb + fr] = f2bf(hv); }
            }
            {
                const float w_old = garr[257], cm63 = garr[256];
#pragma unroll
                for (int ct = 0; ct < 3; ++ct) C[ct] *= w_old;
#pragma unroll
                for (int ksn = 0; ksn < 2; ++ksn) {
                    LAS unsigned char* kb = ks + (32 * ksn + 8 * g + q4) * RS + (16 * wave + 4 * p4) * 2;
                    const bf16x8 kraw = tr8(kb, kb + 4 * RS);
                    const f32x4 u0 = *(const LAS f32x4*)(garr + 32 * ksn + 8 * g), u1 = *(const LAS f32x4*)(garr + 32 * ksn + 8 * g + 4);
                    u32x4 ka;
                    ka.x = cvt_pk_bf16(bf1((bf16_t)kraw[0]) * __expf(u0.x - cm63), bf1((bf16_t)kraw[1]) * __expf(u0.y - cm63));
                    ka.y = cvt_pk_bf16(bf1((bf16_t)kraw[2]) * __expf(u0.z - cm63), bf1((bf16_t)kraw[3]) * __expf(u0.w - cm63));
                    ka.z = cvt_pk_bf16(bf1((bf16_t)kraw[4]) * __expf(u1.x - cm63), bf1((bf16_t)kraw[5]) * __expf(u1.y - cm63));
                    ka.w = cvt_pk_bf16(bf1((bf16_t)kraw[6]) * __expf(u1.z - cm63), bf1((bf16_t)kraw[7]) * __expf(u1.w - cm63));
                    const bf16x8 kf = __builtin_bit_cast(bf16x8, ka);
                    LAS unsigned char* vb = vs + (32 * ksn + 8 * g + q4) * VS + 8 * p4;
#pragma unroll
                    for (int ct = 0; ct < 3; ++ct) { const bf16x8 vf = tr8(vb + 32 * ct, vb + 32 * ct + 4 * VS); C[ct] = mfma16(kf, vf, C[ct]); }
                }
            }
            __syncthreads();
#pragma unroll
            for (int ct = 0; ct < 3; ++ct) { u32x2 w; w.x = cvt_pk_bf16(C[ct][0], C[ct][1]); w.y = cvt_pk_bf16(C[ct][2], C[ct][3]);
                *(LAS u32x2*)(cbs + (16 * ct + fr) * RS + (16 * wave + 4 * g) * 2) = w; }
        }
#undef ML_PREFETCH
    }
}

DI void ph_mnorm(const Ctx cx, const Params& p) {
    bf16_t* Hb = slot(p, 5); const bf16_t* MO = slot(p, 2); const bf16_t* MZ = slot(p, 3);
    const int wave = cx.tid >> 6, lane = cx.tid & 63;
    const int gw = cx.bid * 8 + wave, NGW = cx.nb * 8;
    for (int row = gw; row < M_TOK; row += NGW) {
#pragma unroll
        for (int j = 0; j < 4; ++j) { const size_t o = (size_t)row * DM + 512 * j + 8 * lane;
            const u32x4 hq = *(const u32x4*)(Hb + o), oq = *(const u32x4*)(MO + o), zq = *(const u32x4*)(MZ + o);
            float cv[8]; float ss = 0.f;
#pragma unroll
            for (int e = 0; e < 4; ++e) { cv[2 * e] = sigmoidf_(bf_lo(oq[e])) * bf_lo(hq[e]); cv[2 * e + 1] = sigmoidf_(bf_hi(oq[e])) * bf_hi(hq[e]);
                ss += cv[2 * e] * cv[2 * e] + cv[2 * e + 1] * cv[2 * e + 1]; }
#pragma unroll
            for (int of = 1; of < 32; of <<= 1) ss += __shfl_xor(ss, of);
            const float rinv = rsqrtf(ss * (1.f / 256.f) + 1e-6f);
            const f32x4 g0 = *(const f32x4*)(p.mnorm_g + 512 * j + 8 * lane), g1 = *(const f32x4*)(p.mnorm_g + 512 * j + 8 * lane + 4);
            u32x4 res;
            res.x = cvt_pk_bf16(cv[0] * rinv * g0.x * siluf_(bf_lo(zq.x)), cv[1] * rinv * g0.y * siluf_(bf_hi(zq.x)));
            res.y = cvt_pk_bf16(cv[2] * rinv * g0.z * siluf_(bf_lo(zq.y)), cv[3] * rinv * g0.w * siluf_(bf_hi(zq.y)));
            res.z = cvt_pk_bf16(cv[4] * rinv * g1.x * siluf_(bf_lo(zq.z)), cv[5] * rinv * g1.y * siluf_(bf_hi(zq.z)));
            res.w = cvt_pk_bf16(cv[6] * rinv * g1.z * siluf_(bf_lo(zq.w)), cv[7] * rinv * g1.w * siluf_(bf_hi(zq.w)));
            *(u32x4*)(Hb + o) = res; }
    }
}

DI void ph_fin(const Ctx cx, const Params& p) {
    const int wave = cx.tid >> 6, lane = cx.tid & 63;
    const int gw = cx.bid * 8 + wave, NGW = cx.nb * 8;
    for (int row = gw; row < M_TOK; row += NGW) {
        f32x4* xr = (f32x4*)(p.out + (size_t)row * DM) + lane;
        f32x4 v[8]; float s = 0.f;
#pragma unroll
        for (int j = 0; j < 8; ++j) { v[j] = xr[64 * j]; s += (v[j].x * v[j].x + v[j].y * v[j].y) + (v[j].z * v[j].z + v[j].w * v[j].w); }
        s = wave_sum(s);
        const float rstd = rsqrtf(s * (1.f / DM) + 1e-6f);
#pragma unroll
        for (int j = 0; j < 8; ++j) { const f32x4 g4 = ((const f32x4*)p.final_g)[64 * j + lane]; xr[64 * j] = (v[j] * rstd) * g4; }
    }
}

__global__ void __launch_bounds__(512, 2) hybrid_block_fwd(Params p) {
    extern __shared__ __attribute__((aligned(16))) unsigned char shm[];
    LAS unsigned char* lds = (LAS unsigned char*)shm;
    cg::grid_group grid = cg::this_grid();
    for (int ph = p.ph_lo; ph < p.ph_hi; ++ph) {
        if (ph > p.ph_lo) grid.sync();
        Ctx cx; cx.tid = threadIdx.x; cx.bid = blockIdx.x; cx.nb = gridDim.x;
        asm volatile("" : "+v"(cx.tid)); asm volatile("" : "+s"(cx.bid)); asm volatile("" : "+s"(cx.nb));
#ifndef ONLY_PHASE
#define ONLY_PHASE -1
#endif
#define PHEN(k) (ONLY_PHASE < 0 || ONLY_PHASE == (k))
        switch (ph) {
        case 0: if (PHEN(0)) ph_prep(cx, p, lds); break;
        case 1: case 4: case 8: if (PHEN(1)) {
            const int grp = ph == 1 ? 0 : (ph == 4 ? 1 : 2);
            EpiSplitBf16 E; E.O = slot(p, 0); E.seg_stride = SLOT / 2;
            run_gemm(cx, lds, (const bf16_t*)p.out, (const bf16_t*)(p.ws + WS_WINT) + (size_t)grp * 8192 * DM, grp == 2 ? 4096 : 8192, DM, E);
        } break;
        case 2: if (PHEN(2)) ph_attn(cx, p, lds); break;
        case 3: if (PHEN(3)) ph_comb(cx, p); break;
        case 5: if (PHEN(5)) ph_conv(cx, p); break;
        case 6: if (PHEN(6)) ph_mlstm(cx, p, lds); break;
        case 7: if (PHEN(7)) ph_mnorm(cx, p); break;
        case 9: if (PHEN(9)) { EpiGate<0> E; E.gate = slot(p, 0); E.T = (float*)slot(p, 3); E.O = nullptr;
            run_gemm(cx, lds, slot(p, 7), (const bf16_t*)(p.ws + WS_WA), DM, DM, E); } break;
        case 10: if (PHEN(10)) { EpiGate<1> E; E.gate = slot(p, 1); E.T = (float*)slot(p, 3); E.O = slot(p, 2);
            run_gemm(cx, lds, slot(p, 5), (const bf16_t*)(p.ws + WS_WM), DM, DM, E); } break;
        case 11: if (PHEN(11)) { EpiResid E; E.x = p.x; E.out = p.out;
            run_gemm(cx, lds, slot(p, 2), (const bf16_t*)(p.ws + WS_WO), DM, DM, E); } break;
        case 12: if (PHEN(12)) ph_fin(cx, p); break;
        default: break;
        }
    }
}

extern "C" void kernel_launch(void* const* d_in, const int* in_sizes, int n_in, void* d_out, int out_size, void* d_ws, size_t ws_size, hipStream_t stream) {
    static int grid = 0;
    if (grid == 0) {
        int dev = 0, cus = 0, per_cu = 0;
        (void)hipGetDevice(&dev);
        (void)hipDeviceGetAttribute(&cus, hipDeviceAttributeMultiprocessorCount, dev);
        (void)hipFuncSetAttribute((const void*)hybrid_block_fwd, hipFuncAttributeMaxDynamicSharedMemorySize, LDS_BYTES);
        if (hipOccupancyMaxActiveBlocksPerMultiprocessor(&per_cu, (const void*)hybrid_block_fwd, 512, LDS_BYTES) != hipSuccess || per_cu < 1) { (void)hipGetLastError(); per_cu = 1; }
        if (per_cu > 1) per_cu = 1;
        grid = cus * per_cu;
        if (ws_size < WS_SLOT + 8 * SLOT) fprintf(stderr, "kernel_launch: workspace too small: %zu\n", ws_size);
    }
    Params p{};
    p.x = (const float*)d_in[0]; p.norm_g = (const float*)d_in[1]; p.w_in = (const float*)d_in[2]; p.b_if = (const float*)d_in[3];
    p.conv_w = (const float*)d_in[4]; p.conv_b = (const float*)d_in[5]; p.mnorm_g = (const float*)d_in[6]; p.w_attn = (const float*)d_in[7];
    p.w_mlstm = (const float*)d_in[8]; p.w_out = (const float*)d_in[9]; p.final_g = (const float*)d_in[10];
    p.out = (float*)d_out; p.ws = (unsigned char*)d_ws; p.ph_lo = 0; p.ph_hi = NPHASE;
    void* args[] = {&p};
    hipError_t e = hipLaunchCooperativeKernel((const void*)hybrid_block_fwd, dim3(grid), dim3(512), args, LDS_BYTES, stream);
    if (e != hipSuccess) fprintf(stderr, "cooperative launch failed: %s (grid %d)\n", hipGetErrorString(e), grid);
}
```

```cpp
#include <hip/hip_runtime.h>
#include <hip/hip_cooperative_groups.h>
#include <cstdio>
#include <type_traits>
namespace cg = cooperative_groups;
namespace pg8 {
#define PG8_LAS __attribute__((address_space(3)))
typedef unsigned short bf16_t;
typedef short bf16x8 __attribute__((ext_vector_type(8)));
typedef float f32x4 __attribute__((ext_vector_type(4)));
typedef unsigned u32x4 __attribute__((ext_vector_type(4)));
constexpr int BM = 256, BK = 64, HALF = 128, HTB = HALF * BK * 2  , STAGE_BYTES = 8 * HTB, NXCD = 8, WGM = 8;

__host__ __device__ __forceinline__ int lds_byte(int r, int c) { const int st = (r >> 4) * 2 + (c >> 5), rr = r & 15, cc = c & 31, ob = rr * 64 + cc * 2; return st * 1024 + (ob ^ (((ob >> 9) & 1) << 5)); }
__host__ __device__ __forceinline__ void stage_rc(int b, int& R, int& C) { const int st = b / 1024, sb = b % 1024, swz = sb ^ (((sb >> 9) & 1) << 5); R = (st >> 1) * 16 + swz / 64; C = (st & 1) * 32 + (swz % 64) / 2; }
__host__ __device__ __forceinline__ int perm32(int rho) { const int n = rho >> 4, i = rho & 15; return 8 * (i >> 2) + 4 * n + (i & 3); }

struct Unit { int pm, pn; };
struct Gemm { const bf16_t* A; const bf16_t* Bt; int M, N, K; const bf16_t* A2; const bf16_t* Bt2; };

struct StaticOrder {
    int nM, nN, nwg, G, c;
    __host__ __device__ void init(int M, int N, int G_, int c_) { nM = M / BM; nN = N / BM; nwg = nM * nN; G = G_; c = c_; }
    __host__ __device__ bool next(int i, Unit& u) const {
        const long L = (long)i * G + c; if (L >= nwg) return false;
        int wgid = (int)L; { const int q = nwg / NXCD, r = nwg % NXCD, xcd = wgid % NXCD, off = wgid / NXCD; wgid = (xcd < r ? xcd * (q + 1) : r * (q + 1) + (xcd - r) * q) + off; }
        const int nig = WGM * nN, gid = wgid / nig, fm = gid * WGM, gsz = (nM - fm) < WGM ? (nM - fm) : WGM;
        u.pm = fm + ((wgid % nig) % gsz); u.pn = (wgid % nig) / gsz; return true;
    }
    __device__ __forceinline__ void a_ready(const Unit&) const {}
    __device__ __forceinline__ void done(const Unit&) const {}
};
typedef __bf16 bf16x2v_t __attribute__((ext_vector_type(2)));
typedef float f32x2v_t __attribute__((ext_vector_type(2)));
__device__ __forceinline__ unsigned cvt_pk_bf16(float lo, float hi) { const f32x2v_t f = {lo, hi}; const bf16x2v_t b = __builtin_convertvector(f, bf16x2v_t); return __builtin_bit_cast(unsigned, b); }
typedef float f32x2 __attribute__((ext_vector_type(2)));
template <class Epi, class Sched, bool STAMP = false>
__device__ __forceinline__ void gemm_phase(PG8_LAS unsigned char* lds, const Gemm g, const Sched& S, const Epi& E, unsigned long long* stamps, const int tid_in) {
    const int tid = tid_in, wid = __builtin_amdgcn_readfirstlane(tid >> 6), lane = tid & 63, wr = wid >> 2, wc = wid & 3, fr = lane & 15, fq = lane >> 4;
    const int K = g.K, nth = K / BK, nt = g.A2 ? 2 * nth : nth;
    int ts_lo = 0, ts_hi = 0, nts = 0; const unsigned long long rt_entry = STAMP ? (unsigned long long)wall_clock64() : 0ull;
#define PG8_STAMP() do { if (STAMP && wid == 0 && nts < 64) { const unsigned long long _c = (unsigned long long)clock64(); \
        ts_lo = (lane == nts) ? (int)(unsigned)_c : ts_lo; ts_hi = (lane == nts) ? (int)(unsigned)(_c >> 32) : ts_hi; ++nts; } } while (0)
    PG8_STAMP();
    unsigned voffA[2], voffB[2];
#pragma unroll
    for (int i = 0; i < 2; ++i) { int R, C; stage_rc(tid * 16 + i * 8192, R, C); const int Rb = Epi::PERM ? ((R & ~31) + perm32(R & 31)) : R;
        voffA[i] = (unsigned)(R * K + C) * 2u; voffB[i] = (unsigned)(Rb * K + C) * 2u; }
    const size_t kstep = (size_t)(BK * 2);
    const size_t hstep = (size_t)HALF * K * 2;
    const size_t tstep = 2 * hstep;
    const unsigned ldsw = (unsigned)wid * 1024u;
    const int aoff = lds_byte(wr * 64 + fr, fq * 8), boff = lds_byte(wc * 32 + fr, fq * 8);
#define PG8_SA(b, h) (((b) * 2 + (h)) * HTB)
#define PG8_SB(b, h) ((4 + (b) * 2 + (h)) * HTB)
#define PG8_STAGE(bufoff, gbase, voff) do { _Pragma("unroll") for (int _i = 0; _i < 2; ++_i) \
        __builtin_amdgcn_global_load_lds((const unsigned*)((const char*)(gbase) + (voff)[_i]), (PG8_LAS unsigned*)(lds + (bufoff) + ldsw + _i * 8192), 16, 0, 0); } while (0)
#define PG8_LDA(dst, b, h) do { _Pragma("unroll") for (int m = 0; m < 4; ++m) _Pragma("unroll") for (int k = 0; k < 2; ++k) dst[m][k] = *(const PG8_LAS bf16x8*)(lds + PG8_SA(b, h) + aoff + m * 2048 + k * 1024); } while (0)
#define PG8_LDB(dst, b, h) do { _Pragma("unroll") for (int n = 0; n < 2; ++n) _Pragma("unroll") for (int k = 0; k < 2; ++k) dst[n][k] = *(const PG8_LAS bf16x8*)(lds + PG8_SB(b, h) + boff + n * 2048 + k * 1024); } while (0)
#define PG8_MMA(ai, bj, At, Bt) do { __builtin_amdgcn_s_setprio(1); _Pragma("unroll") for (int m = 0; m < 4; ++m) _Pragma("unroll") for (int n = 0; n < 2; ++n) _Pragma("unroll") for (int k = 0; k < 2; ++k) \
        acc[ai][bj][m][n] = __builtin_amdgcn_mfma_f32_16x16x32_bf16(Bt[n][k], At[m][k], acc[ai][bj][m][n], 0, 0, 0); __builtin_amdgcn_s_setprio(0); } while (0)
#define PG8_WAIT_V(n) asm volatile("s_waitcnt vmcnt(" #n ")" ::: "memory")
#define PG8_WAIT_L(n) asm volatile("s_waitcnt lgkmcnt(" #n ")" ::: "memory")
#define PG8_BAR __builtin_amdgcn_s_barrier()
#define PG8_SCHED __builtin_amdgcn_sched_barrier(0)
    Unit cur, nxt; int ui = 0;
    if (!S.next(0, cur)) return;
    f32x4 acc[2][2][4][2];
#pragma unroll
    for (int a = 0; a < 2; ++a)
#pragma unroll
        for (int b = 0; b < 2; ++b)
#pragma unroll
            for (int m = 0; m < 4; ++m)
#pragma unroll
                for (int n = 0; n < 2; ++n) acc[a][b][m][n] = (f32x4){0.f, 0.f, 0.f, 0.f};
    bf16x8 At[4][2], B0[2][2], B1[2][2];
    const char* cA = (const char*)g.A + (size_t)cur.pm * tstep; const char* cB = (const char*)g.Bt + (size_t)cur.pn * tstep;
    const char* cA2 = g.A2 ? (const char*)g.A2 + (size_t)cur.pm * tstep : cA; const char* cB2 = g.Bt2 ? (const char*)g.Bt2 + (size_t)cur.pn * tstep : cB;
#define PG8_KT(u1, u2, tix) ((tix) < nth ? (u1) + (size_t)(tix) * kstep : (u2) + (size_t)((tix) - nth) * kstep)
    S.a_ready(cur);
    PG8_STAGE(PG8_SB(0, 0), cB, voffB); PG8_STAGE(PG8_SA(0, 0), cA, voffA); PG8_STAGE(PG8_SB(0, 1), cB + hstep, voffB); PG8_STAGE(PG8_SA(0, 1), cA + hstep, voffA);
    if (wr == 1) PG8_BAR;
    PG8_WAIT_V(4); PG8_BAR;
    PG8_STAGE(PG8_SB(1, 0), cB + kstep, voffB); PG8_STAGE(PG8_SA(1, 0), cA + kstep, voffA); PG8_STAGE(PG8_SB(1, 1), cB + hstep + kstep, voffB);
    PG8_WAIT_V(6); PG8_BAR;
    PG8_STAMP();
    for (;;) {
        const bool has_next = S.next(ui + 1, nxt);
        const char* nA = has_next ? (const char*)g.A + (size_t)nxt.pm * tstep : cA; const char* nB = has_next ? (const char*)g.Bt + (size_t)nxt.pn * tstep : cB;
        for (int t = 0; t < nt; t += 2) {
            const bool last = (t == nt - 2);
            if constexpr (Epi::HAS_MID) { if (t == nth) { PG8_SCHED; E.mid(acc, cur, wr, wc, fr, fq); PG8_SCHED; } }
            const char* a1 = PG8_KT(cA, cA2, t + 1);
            const char* a2 = last ? nA : PG8_KT(cA, cA2, t + 2); const char* b2 = last ? nB : PG8_KT(cB, cB2, t + 2);
            const char* a3 = last ? nA + kstep : PG8_KT(cA, cA2, t + 3); const char* b3 = last ? nB + kstep : PG8_KT(cB, cB2, t + 3);
            if (last && has_next) S.a_ready(nxt);
            PG8_LDB(B0, 0, 0); PG8_SCHED; PG8_LDA(At, 0, 0); PG8_STAGE(PG8_SA(1, 1), a1 + hstep, voffA);
            PG8_WAIT_L(8); PG8_BAR; PG8_WAIT_L(0); PG8_MMA(0, 0, At, B0); PG8_BAR; PG8_SCHED;
            PG8_LDB(B1, 0, 1); PG8_STAGE(PG8_SB(0, 0), b2, voffB);
            PG8_BAR; PG8_WAIT_L(0); PG8_MMA(0, 1, At, B1); PG8_BAR;
            PG8_LDA(At, 0, 1); PG8_STAGE(PG8_SA(0, 0), a2, voffA);
            PG8_BAR; PG8_WAIT_L(0); PG8_MMA(1, 0, At, B0); PG8_BAR; PG8_SCHED;
            PG8_STAGE(PG8_SB(0, 1), b2 + hstep, voffB);
            PG8_WAIT_V(6); PG8_BAR; PG8_MMA(1, 1, At, B1); PG8_BAR;
            PG8_LDB(B0, 1, 0); PG8_SCHED; PG8_LDA(At, 1, 0); PG8_STAGE(PG8_SA(0, 1), a2 + hstep, voffA);
            PG8_WAIT_L(8); PG8_BAR; PG8_WAIT_L(0); PG8_MMA(0, 0, At, B0); PG8_BAR; PG8_SCHED;
            PG8_LDB(B1, 1, 1); PG8_STAGE(PG8_SB(1, 0), b3, voffB);
            PG8_BAR; PG8_WAIT_L(0); PG8_MMA(0, 1, At, B1); PG8_BAR;
            PG8_LDA(At, 1, 1); PG8_STAGE(PG8_SA(1, 0), a3, voffA);
            PG8_BAR; PG8_WAIT_L(0); PG8_MMA(1, 0, At, B0); PG8_BAR; PG8_SCHED;
            PG8_STAGE(PG8_SB(1, 1), b3 + hstep, voffB);
            PG8_WAIT_V(6); PG8_BAR; PG8_MMA(1, 1, At, B1); PG8_BAR;
        }
        PG8_STAMP();
        if constexpr (!Epi::AFTER_DRAIN) { E(acc, cur, wr, wc, fr, fq); S.done(cur); }
        PG8_STAMP();
        if (!has_next) break;
#pragma unroll
        for (int a = 0; a < 2; ++a)
#pragma unroll
            for (int b = 0; b < 2; ++b)
#pragma unroll
                for (int m = 0; m < 4; ++m)
#pragma unroll
                    for (int n = 0; n < 2; ++n) acc[a][b][m][n] = (f32x4){0.f, 0.f, 0.f, 0.f};
        cur = nxt; cA = nA; cB = nB; ++ui;
        cA2 = g.A2 ? (const char*)g.A2 + (size_t)cur.pm * tstep : cA; cB2 = g.Bt2 ? (const char*)g.Bt2 + (size_t)cur.pn * tstep : cB;
    }
    PG8_WAIT_V(0);
    if (wr == 0) PG8_BAR;
    PG8_BAR;
    if constexpr (Epi::AFTER_DRAIN) { E.fused(acc, cur, wr, wc, fr, fq, lds, wid, lane); S.done(cur); }
    PG8_STAMP();
    if (STAMP && wid == 0) { stamps[lane] = lane < nts ? (((unsigned long long)(unsigned)ts_hi << 32) | (unsigned)ts_lo) : 0ull;
        if (lane == 62) stamps[62] = rt_entry; if (lane == 63) stamps[63] = (unsigned long long)wall_clock64(); }
#undef PG8_STAMP
#undef PG8_SA
#undef PG8_SB
#undef PG8_STAGE
#undef PG8_LDA
#undef PG8_LDB
#undef PG8_MMA
#undef PG8_WAIT_V
#undef PG8_WAIT_L
#undef PG8_BAR
#undef PG8_SCHED
#undef PG8_KT
}
}


using pg8::bf16_t; using pg8::bf16x8; using pg8::f32x4; using pg8::u32x4; using pg8::cvt_pk_bf16;
typedef short s16x4 __attribute__((ext_vector_type(4)));
typedef unsigned u32x2 __attribute__((ext_vector_type(2)));
#define LAS __attribute__((address_space(3)))
#define DI __device__ __forceinline__
#define XB_TMO      128
#define XB_XCNT(j)  (256  + 64 * (j))
#define XB_XSUB(j)  (1280 + 64 * (j))
#define XB_XGEN(j)  (2304 + 64 * (j))
#define XB_TOP      3328
#define XB_TOPGEN   3392
#define XCD_BAR_WORDS 3456
#define XB_SPIN_CAP (1u << 22)

__device__ __forceinline__ unsigned xb_ld(unsigned* p)              { return __hip_atomic_load(p, __ATOMIC_RELAXED, __HIP_MEMORY_SCOPE_AGENT); }
__device__ __forceinline__ unsigned xb_add(unsigned* p, unsigned v) { return __hip_atomic_fetch_add(p, v, __ATOMIC_RELAXED, __HIP_MEMORY_SCOPE_AGENT); }
__device__ __forceinline__ unsigned xb_xcc_id() { return (unsigned)__builtin_amdgcn_s_getreg((3 << 11) | 20) & 0xFu; }
#define XB_SPIN(cond, bar) do { unsigned _sp = 0; while (cond) { __builtin_amdgcn_s_sleep(1); \
    if ((++_sp & 255u) == 0u) { if (xb_ld(&(bar)[XB_TMO])) break; if (_sp > XB_SPIN_CAP) { atomicAdd(&(bar)[XB_TMO], 1u); break; } } } } while (0)

struct XcdBarrier {
    unsigned* bar; unsigned x;
    volatile LAS unsigned* st;
};

__device__ __forceinline__ XcdBarrier xcd_barrier_post(unsigned* bar, volatile LAS unsigned* st) {
    XcdBarrier b; b.bar = bar; b.x = xb_xcc_id(); b.st = st;
    if (threadIdx.x == 0) (void)xb_add(&bar[XB_XCNT(b.x)], 1u);
    return b;
}
__device__ __forceinline__ void xcd_barrier_complete(unsigned* bar, unsigned x, unsigned& nloc, unsigned& nx) {
    const unsigned G = gridDim.x * gridDim.y * gridDim.z;
    unsigned sum, cnt, mine, sp = 0u;
    for (;;) {
        sum = 0u; cnt = 0u; mine = 0u;
#pragma unroll
        for (unsigned j = 0; j < 16; ++j) { const unsigned c = xb_ld(&bar[XB_XCNT(j)]); sum += c; cnt += (c > 0u) ? 1u : 0u; mine = (j == x) ? c : mine; }
        if (sum == G) break;
        __builtin_amdgcn_s_sleep(1);
        if ((++sp & 255u) == 0u) { if (xb_ld(&bar[XB_TMO])) break; if (sp > XB_SPIN_CAP) { atomicAdd(&bar[XB_TMO], 1u); break; } }
    }
    nloc = mine > 0u ? mine : 1u; nx = cnt > 0u ? cnt : 1u;
}

__device__ __forceinline__ void xcd_barrier(const XcdBarrier& b) {
    asm volatile("s_waitcnt vmcnt(0)" ::: "memory");
    __syncthreads();
    if (threadIdx.x == 0) {
        unsigned* bar = b.bar;
        __builtin_amdgcn_s_waitcnt(0);
        unsigned nloc = b.st[0], nx = b.st[1];
        if (nloc == 0u) { xcd_barrier_complete(bar, b.x, nloc, nx); b.st[0] = nloc; b.st[1] = nx; }
        const unsigned old = xb_add(&bar[XB_XSUB(b.x)], 1u);
        const unsigned gen = old / nloc;
        if (old + 1u == (gen + 1u) * nloc) {
            __builtin_amdgcn_fence(__ATOMIC_RELEASE, "agent");
            asm volatile("s_waitcnt vmcnt(0)" ::: "memory");
            const unsigned og = xb_add(&bar[XB_TOP], 1u);
            const unsigned tg = og / nx;
            if (og + 1u == (tg + 1u) * nx) xb_add(&bar[XB_TOPGEN], 1u);
            else XB_SPIN(xb_ld(&bar[XB_TOPGEN]) == tg, bar);
            __builtin_amdgcn_fence(__ATOMIC_ACQUIRE, "agent");
            xb_add(&bar[XB_XGEN(b.x)], 1u);
            asm volatile("s_waitcnt vmcnt(0)" ::: "memory");
        } else {
            XB_SPIN(xb_ld(&bar[XB_XGEN(b.x)]) == gen, bar);
            __builtin_amdgcn_fence(__ATOMIC_ACQUIRE, "agent");
            asm volatile("s_waitcnt vmcnt(0)" ::: "memory");
        }
    }
    __syncthreads();
}


constexpr int M_TOK = 16384, DM = 2048, SEQ = 4096, INW = 20496;
constexpr size_t MiB = (size_t)1 << 20;
constexpr size_t WS_WINT = 0, WS_WA = 80 * MiB, WS_WM = 88 * MiB, WS_WO = 96 * MiB, WS_GATES = 104 * MiB, WS_LSE = 105 * MiB, WS_BAR = 108 * MiB, WS_SLOT = 112 * MiB, SLOT = 64 * MiB;
constexpr int LDS_BYTES = 143360 + 16;
constexpr int NPHASE = 13;

struct Params {
    const float *x, *norm_g, *w_in, *b_if, *conv_w, *conv_b, *mnorm_g, *w_attn, *w_mlstm, *w_out, *final_g;
    float* out; unsigned char* ws; int ph_lo, ph_hi;
};

struct Ctx { int tid, bid, nb; };
DI void lds_barrier() { asm volatile("s_waitcnt lgkmcnt(0)" ::: "memory"); __builtin_amdgcn_s_barrier(); asm volatile("" ::: "memory"); }
DI float bf_lo(unsigned u) { return __uint_as_float(u << 16); }
DI float bf_hi(unsigned u) { return __uint_as_float(u & 0xffff0000u); }
DI float bf1(bf16_t b) { return __uint_as_float(((unsigned)b) << 16); }
DI bf16_t f2bf(float f) { return (bf16_t)(cvt_pk_bf16(f, 0.f) & 0xffffu); }
DI float sigmoidf_(float z) { return __builtin_amdgcn_rcpf(1.f + __expf(-z)); }
DI float siluf_(float z) { return z * sigmoidf_(z); }
DI float wave_sum(float v) {
#pragma unroll
    for (int o = 1; o < 64; o <<= 1) v += __shfl_xor(v, o);
    return v;
}
DI bf16_t* slot(const Params& p, int i) { return (bf16_t*)(p.ws + WS_SLOT + (size_t)i * SLOT); }
DI f32x4 mfma16(bf16x8 a, bf16x8 b, f32x4 c) { return __builtin_amdgcn_mfma_f32_16x16x32_bf16(a, b, c, 0, 0, 0); }
DI bf16x8 tr8(LAS unsigned char* lo, LAS unsigned char* hi) {
    s16x4 a = __builtin_amdgcn_ds_read_tr16_b64_v4i16((LAS s16x4*)lo);
    s16x4 b = __builtin_amdgcn_ds_read_tr16_b64_v4i16((LAS s16x4*)hi);
    return __builtin_shufflevector(a, b, 0, 1, 2, 3, 4, 5, 6, 7);
}

template <bool NT> struct EpiSplitBf16T {
    static constexpr bool PERM = true, AFTER_DRAIN = false, HAS_MID = false;
    bf16_t* O; size_t seg_stride; bf16_t* O4; bf16_t* O5;
    DI void operator()(const f32x4 (&acc)[2][2][4][2], const pg8::Unit& u, int wr, int wc, int fr, int fq) const {
        const int row0 = u.pm * 256 + wr * 64 + fr; int colt = u.pn * 256; const int seg = colt >> 11; colt &= 2047;
        bf16_t* base = seg < 4 ? O + (size_t)seg * seg_stride : (seg == 4 ? O4 : O5); const int col0 = colt + wc * 32 + 8 * fq;
#pragma unroll
        for (int ai = 0; ai < 2; ++ai)
#pragma unroll
            for (int m = 0; m < 4; ++m) { bf16_t* rowp = base + (size_t)(row0 + ai * 128 + m * 16) * DM + col0;
#pragma unroll
                for (int bj = 0; bj < 2; ++bj) { const f32x4 v0 = acc[ai][bj][m][0], v1 = acc[ai][bj][m][1];
                    u32x4 w; w.x = cvt_pk_bf16(v0[0], v0[1]); w.y = cvt_pk_bf16(v0[2], v0[3]); w.z = cvt_pk_bf16(v1[0], v1[1]); w.w = cvt_pk_bf16(v1[2], v1[3]);
                    if (NT) __builtin_nontemporal_store(w, (u32x4*)(rowp + bj * 128)); else *(u32x4*)(rowp + bj * 128) = w; } }
    }
};
template <int MODE> struct EpiGate {
    static constexpr bool PERM = true, AFTER_DRAIN = false, HAS_MID = false;
    const bf16_t* gate; float* T; bf16_t* O;
    DI void operator()(const f32x4 (&acc)[2][2][4][2], const pg8::Unit& u, int wr, int wc, int fr, int fq) const {
        const int row0 = u.pm * 256 + wr * 64 + fr, col0 = u.pn * 256 + wc * 32 + 8 * fq;
#pragma unroll
        for (int ai = 0; ai < 2; ++ai)
#pragma unroll
            for (int m = 0; m < 4; ++m) { const size_t ro = (size_t)(row0 + ai * 128 + m * 16) * DM + col0;
#pragma unroll
                for (int bj = 0; bj < 2; ++bj) { const size_t o = ro + bj * 128;
                    const u32x4 gq = *(const u32x4*)(gate + o);
                    f32x4 v0 = acc[ai][bj][m][0], v1 = acc[ai][bj][m][1];
                    v0[0] *= sigmoidf_(bf_lo(gq.x)); v0[1] *= sigmoidf_(bf_hi(gq.x)); v0[2] *= sigmoidf_(bf_lo(gq.y)); v0[3] *= sigmoidf_(bf_hi(gq.y));
                    v1[0] *= sigmoidf_(bf_lo(gq.z)); v1[1] *= sigmoidf_(bf_hi(gq.z)); v1[2] *= sigmoidf_(bf_lo(gq.w)); v1[3] *= sigmoidf_(bf_hi(gq.w));
                    if (MODE == 0) { *(f32x4*)(T + o) = v0; *(f32x4*)(T + o + 4) = v1; }
                    else { v0 += *(const f32x4*)(T + o); v1 += *(const f32x4*)(T + o + 4);
                        u32x4 w; w.x = cvt_pk_bf16(v0[0], v0[1]); w.y = cvt_pk_bf16(v0[2], v0[3]); w.z = cvt_pk_bf16(v1[0], v1[1]); w.w = cvt_pk_bf16(v1[2], v1[3]);
                        *(u32x4*)(O + o) = w; } } }
    }
};
struct EpiResid {
    static constexpr bool PERM = false, AFTER_DRAIN = false, HAS_MID = false;
    const float* x; float* out;
    DI void operator()(const f32x4 (&acc)[2][2][4][2], const pg8::Unit& u, int wr, int wc, int fr, int fq) const {
        const int row0 = u.pm * 256 + wr * 64 + fr, col0 = u.pn * 256 + wc * 32 + 4 * fq;
#pragma unroll
        for (int ai = 0; ai < 2; ++ai)
#pragma unroll
            for (int m = 0; m < 4; ++m) { const size_t ro = (size_t)(row0 + ai * 128 + m * 16) * DM + col0;
#pragma unroll
                for (int bj = 0; bj < 2; ++bj)
#pragma unroll
                    for (int n = 0; n < 2; ++n) { const size_t o = ro + bj * 128 + n * 16; *(f32x4*)(out + o) = acc[ai][bj][m][n] + *(const f32x4*)(x + o); } }
    }
};
struct EpiMerge2 {
    static constexpr bool PERM = true, AFTER_DRAIN = false, HAS_MID = true;
    const bf16_t* ga; const bf16_t* gm; bf16_t* O;
    DI void mid(f32x4 (&acc)[2][2][4][2], const pg8::Unit& u, int wr, int wc, int fr_, int fq) const {
        int fr = fr_; asm volatile("" : "+v"(fr));
        const int row0 = u.pm * 256 + wr * 64 + fr, col0 = u.pn * 256 + wc * 32 + 8 * fq;
#pragma unroll
        for (int ai = 0; ai < 2; ++ai)
#pragma unroll
            for (int m = 0; m < 4; ++m) { const size_t ro = (size_t)(row0 + ai * 128 + m * 16) * DM + col0;
#pragma unroll
                for (int bj = 0; bj < 2; ++bj) { const size_t o = ro + bj * 128;
                    const u32x4 aq = *(const u32x4*)(ga + o), mq = *(const u32x4*)(gm + o);
#pragma unroll
                    for (int e = 0; e < 4; ++e) {
                        const float rl = (1.f + __expf(-bf_lo(mq[e]))) * __builtin_amdgcn_rcpf(1.f + __expf(-bf_lo(aq[e])));
                        const float rh = (1.f + __expf(-bf_hi(mq[e]))) * __builtin_amdgcn_rcpf(1.f + __expf(-bf_hi(aq[e])));
                        acc[ai][bj][m][e >> 1][(2 * e) & 3] *= rl; acc[ai][bj][m][e >> 1][((2 * e) & 3) + 1] *= rh; } }
                asm volatile("" ::: "memory"); }
    }
    DI void operator()(const f32x4 (&acc)[2][2][4][2], const pg8::Unit& u, int wr, int wc, int fr_, int fq) const {
        int fr = fr_; asm volatile("" : "+v"(fr));
        const int row0 = u.pm * 256 + wr * 64 + fr, col0 = u.pn * 256 + wc * 32 + 8 * fq;
#pragma unroll
        for (int ai = 0; ai < 2; ++ai)
#pragma unroll
            for (int m = 0; m < 4; ++m) { const size_t ro = (size_t)(row0 + ai * 128 + m * 16) * DM + col0;
#pragma unroll
                for (int bj = 0; bj < 2; ++bj) { const size_t o = ro + bj * 128;
                    const u32x4 gq = *(const u32x4*)(gm + o);
                    const f32x4 v0 = acc[ai][bj][m][0], v1 = acc[ai][bj][m][1];
                    u32x4 w; w.x = cvt_pk_bf16(v0[0] * sigmoidf_(bf_lo(gq.x)), v0[1] * sigmoidf_(bf_hi(gq.x))); w.y = cvt_pk_bf16(v0[2] * sigmoidf_(bf_lo(gq.y)), v0[3] * sigmoidf_(bf_hi(gq.y)));
                    w.z = cvt_pk_bf16(v1[0] * sigmoidf_(bf_lo(gq.z)), v1[1] * sigmoidf_(bf_hi(gq.z))); w.w = cvt_pk_bf16(v1[2] * sigmoidf_(bf_lo(gq.w)), v1[3] * sigmoidf_(bf_hi(gq.w)));
                    *(u32x4*)(O + o) = w; } }
    }
};
template <class Epi> DI void run_gemm(const Ctx cx, LAS unsigned char* lds, const bf16_t* A, const bf16_t* Bt, int N, int K, const Epi& E, const bf16_t* A2 = nullptr, const bf16_t* Bt2 = nullptr) {
    pg8::Gemm g; g.A = A; g.Bt = Bt; g.M = M_TOK; g.N = N; g.K = K; g.A2 = A2; g.Bt2 = Bt2;
    pg8::StaticOrder S; S.init(M_TOK, N, cx.nb, cx.bid);
    pg8::gemm_phase<Epi, pg8::StaticOrder, false>(lds, g, S, E, nullptr, cx.tid);
}

DI void transpose_item(const float* W, int ldw, int sc0, bf16_t* WT, int dr0, int kb, LAS float* scr, int lane) {
    const int k0 = 64 * kb;
    float t[64];
#pragma unroll
    for (int i = 0; i < 64; ++i) t[i] = __builtin_nontemporal_load(W + (size_t)(k0 + i) * ldw + sc0 + lane);
#pragma unroll
    for (int i = 0; i < 64; ++i) scr[i * 65 + lane] = t[i];
    asm volatile("s_waitcnt lgkmcnt(0)" ::: "memory");
    const int c = lane & 7;
#pragma unroll
    for (int j = 0; j < 8; ++j) { const int n = (lane >> 3) + 8 * j; const LAS float* s = scr + (8 * c) * 65 + n;
        u32x4 o; o.x = cvt_pk_bf16(s[0 * 65], s[1 * 65]); o.y = cvt_pk_bf16(s[2 * 65], s[3 * 65]); o.z = cvt_pk_bf16(s[4 * 65], s[5 * 65]); o.w = cvt_pk_bf16(s[6 * 65], s[7 * 65]);
        *(u32x4*)(WT + (size_t)(dr0 + n) * DM + k0 + 8 * c) = o; }
    asm volatile("s_waitcnt lgkmcnt(0)" ::: "memory");
}
DI float reduce16_cols(const f32x4 (&a)[4], int lane) {
    float t8[8];
#pragma unroll
    for (int c = 0; c < 8; ++c) { const float lo = a[c >> 2][c & 3], hi = a[(c + 8) >> 2][c & 3]; const bool up = (lane & 32) != 0;
        const float keep = up ? hi : lo, give = up ? lo : hi; t8[c] = keep + __shfl_xor(give, 32); }
    float t4[4];
#pragma unroll
    for (int c = 0; c < 4; ++c) { const bool up = (lane & 16) != 0; const float keep = up ? t8[c + 4] : t8[c], give = up ? t8[c] : t8[c + 4]; t4[c] = keep + __shfl_xor(give, 16); }
    float t2[2];
#pragma unroll
    for (int c = 0; c < 2; ++c) { const bool up = (lane & 8) != 0; const float keep = up ? t4[c + 2] : t4[c], give = up ? t4[c] : t4[c + 2]; t2[c] = keep + __shfl_xor(give, 8); }
    const bool up = (lane & 4) != 0; const float keep = up ? t2[1] : t2[0], give = up ? t2[0] : t2[1];
    float t1 = keep + __shfl_xor(give, 4);
    t1 += __shfl_xor(t1, 2); t1 += __shfl_xor(t1, 1);
    return t1;
}
DI void ph_prep(const Ctx cx, const Params& p, LAS unsigned char* lds) {
    const int tid = cx.tid, wave = tid >> 6, lane = tid & 63;
    const int gw = cx.bid * 8 + wave, NGW = cx.nb * 8;
    constexpr int PREP_RB = 5;
    const bool split = cx.nb == 256; const int xcd_ = cx.bid & 7, jb = cx.bid >> 3, grp8 = xcd_ * 4 + (jb >> 3), r8 = jb & 7;
    const bool do_rows = !split || r8 < PREP_RB, do_tr = !split || r8 >= PREP_RB;
    const int gwr = split ? (grp8 * PREP_RB + r8) * 8 + wave : gw, NGWR = split ? 32 * PREP_RB * 8 : NGW;
    const int NGWT = split ? 32 * (8 - PREP_RB) * 8 : NGW;
    bf16_t* hn = (bf16_t*)p.out;
    float* ig = (float*)(p.ws + WS_GATES); float* lf = ig + M_TOK * 8;
    if (do_rows) {
    f32x4 na[8], nb2[8];
#define PR_LOAD(pr_) do { const f32x4* xr_ = (const f32x4*)(p.x + (size_t)(2 * (pr_)) * DM) + lane; \
        _Pragma("unroll") for (int j = 0; j < 8; ++j) { na[j] = __builtin_nontemporal_load(xr_ + 64 * j); nb2[j] = __builtin_nontemporal_load(xr_ + 512 + 64 * j); } } while (0)
    if (gwr < M_TOK / 2) PR_LOAD(gwr);
#pragma unroll
    for (int i = 0; i < 16; ++i) { const int idx = tid + 512 * i, l = idx & 63, rest = idx >> 6, c4 = rest & 3, e = (rest >> 2) & 3, j = rest >> 4;
        *(LAS f32x4*)(lds + (size_t)idx * 16) = *(const f32x4*)(p.w_in + (size_t)(256 * j + 4 * l + e) * INW + 12288 + 4 * c4); }
    __syncthreads();
    for (int pr = gwr; pr < M_TOK / 2; pr += NGWR) {
        const int row = 2 * pr;
        f32x4 va[8], vb[8]; float sa = 0.f, sb = 0.f;
#pragma unroll
        for (int j = 0; j < 8; ++j) { va[j] = na[j]; vb[j] = nb2[j]; }
        const int prn = (pr + NGWR < M_TOK / 2) ? pr + NGWR : pr;
        const f32x4* xrn = (const f32x4*)(p.x + (size_t)(2 * prn) * DM) + lane;
#pragma unroll
        for (int j = 0; j < 8; ++j) { sa += (va[j].x * va[j].x + va[j].y * va[j].y) + (va[j].z * va[j].z + va[j].w * va[j].w);
            sb += (vb[j].x * vb[j].x + vb[j].y * vb[j].y) + (vb[j].z * vb[j].z + vb[j].w * vb[j].w); }
        sa = wave_sum(sa); sb = wave_sum(sb);
        const float rstda = rsqrtf(sa * (1.f / DM) + 1e-6f), rstdb = rsqrtf(sb * (1.f / DM) + 1e-6f);
        f32x4 acca[4], accb[4];
#pragma unroll
        for (int c = 0; c < 4; ++c) { acca[c] = (f32x4){0.f, 0.f, 0.f, 0.f}; accb[c] = (f32x4){0.f, 0.f, 0.f, 0.f}; }
#pragma unroll
        for (int j = 0; j < 8; ++j) {
            const f32x4 g4 = ((const f32x4*)p.norm_g)[64 * j + lane];
            const f32x4 ha = (va[j] * rstda) * g4, hb = (vb[j] * rstdb) * g4;
            na[j] = __builtin_nontemporal_load(xrn + 64 * j); nb2[j] = __builtin_nontemporal_load(xrn + 512 + 64 * j);
            u32x2 pk; pk.x = cvt_pk_bf16(ha.x, ha.y); pk.y = cvt_pk_bf16(ha.z, ha.w);
            *(u32x2*)(hn + (size_t)row * DM + 256 * j + 4 * lane) = pk;
            pk.x = cvt_pk_bf16(hb.x, hb.y); pk.y = cvt_pk_bf16(hb.z, hb.w);
            *(u32x2*)(hn + (size_t)(row + 1) * DM + 256 * j + 4 * lane) = pk;
#pragma unroll
            for (int e = 0; e < 4; ++e) {
#pragma unroll
                for (int c4 = 0; c4 < 4; ++c4) { const f32x4 w = *(const LAS f32x4*)(lds + (size_t)((((j * 4 + e) * 4 + c4) * 64) + lane) * 16);
                    acca[c4] += ha[e] * w; accb[c4] += hb[e] * w; }
                if (e & 1) asm volatile("" ::: "memory"); }
        }
        const float suma = reduce16_cols(acca, lane), sumb = reduce16_cols(accb, lane);
        if ((lane & 3) == 0) { const int col = ((lane >> 5) & 1) * 8 + ((lane >> 4) & 1) * 4 + ((lane >> 3) & 1) * 2 + ((lane >> 2) & 1);
            const float za = suma + p.b_if[col], zb = sumb + p.b_if[col];
            if (col < 8) { ig[(size_t)row * 8 + col] = za; ig[(size_t)(row + 1) * 8 + col] = zb; }
            else { lf[(size_t)row * 8 + col - 8] = fminf(za, 0.f) - log1pf(__expf(-fabsf(za))); lf[(size_t)(row + 1) * 8 + col - 8] = fminf(zb, 0.f) - log1pf(__expf(-fabsf(zb))); } }
    }
#undef PR_LOAD
    }
    __syncthreads();
    if (do_tr) {
    int lane_t = lane, wave_t = wave; asm volatile("" : "+v"(lane_t), "+v"(wave_t));
    LAS float* scr = (LAS float*)(lds + wave_t * 16640);
    constexpr int I_IN = 32 * 320, I_SQ = 32 * 32, NIT = I_IN + 3 * I_SQ;
    const int gwt = split ? (grp8 * (8 - PREP_RB) + (r8 - PREP_RB)) * 8 + wave_t : cx.bid * 8 + wave_t;
    for (int it = gwt; it < NIT; it += NGWT) {
        if (it < I_IN) { const int kb = it / 320, nb = it % 320, n0 = 64 * nb;
            transpose_item(p.w_in, INW, n0 < 12288 ? n0 : n0 + 16, (bf16_t*)(p.ws + WS_WINT), n0, kb, scr, lane_t); }
        else { int r = it - I_IN; const int which = r / I_SQ; r -= which * I_SQ; const int kb = r >> 5, nb = r & 31;
            const float* W = which == 0 ? p.w_attn : (which == 1 ? p.w_mlstm : p.w_out);
            bf16_t* WT = (bf16_t*)(p.ws + (which == 0 ? WS_WA : (which == 1 ? WS_WM : WS_WO)));
            transpose_item(W, DM, 64 * nb, WT, 64 * nb, kb, scr, lane_t); }
    }
    }
}

DI void ph_attn(const Ctx cx, const Params& p, LAS unsigned char* lds) {
    const bf16_t* Qg = slot(p, 0); const bf16_t* Kg = slot(p, 1); const bf16_t* Vg = slot(p, 2);
    float* lse = (float*)(p.ws + WS_LSE);
    const int tid = cx.tid, wave = __builtin_amdgcn_readfirstlane(tid >> 6), lane = tid & 63, fr = lane & 15, g = lane >> 4, q4 = fr >> 2, p4 = fr & 3;
    constexpr int RS = 272, VRS = 288;
    LAS unsigned char* Ks = lds; LAS unsigned char* Vs = lds + 256 * RS;
    const int i0 = wave * 16, w0 = i0 < 96 ? i0 : 96;
    u32x4 pk[8], pv[8]; bf16x8 qf[4];
    const bool fast = cx.nb == 256; const int xcd = cx.bid & 7, cuix = cx.bid >> 3, nit = fast ? 24 : (6144 - cx.bid + cx.nb - 1) / cx.nb;
#define ATT_ITEM(i) (fast ? (((((xcd * 8 + (i) / 3) * 3 + (i) % 3)) << 5) | ((cuix + (i)) & 31)) : cx.bid + (i) * cx.nb)
#define ATT_DECODE(itx) const int blk = (itx) & 31, rest = (itx) >> 5, pat = rest % 3, bh = rest / 3, h = bh & 15, b = bh >> 4; \
        const int sh = 2 * pat, r = 1 << sh, nblk = 32 >> sh, php = blk >> (5 - sh), n = blk & (nblk - 1); const size_t tok0 = (size_t)b * SEQ;
#define ATT_LOADKV(itx) do { ATT_DECODE(itx) \
        _Pragma("unroll") for (int i = 0; i < 8; ++i) { const int idx = tid + 512 * i, row = idx >> 4, ch = idx & 15; int uu = (n - 1) * 128 + row; uu = uu < 0 ? 0 : uu; \
            const size_t go = (tok0 + (size_t)uu * r + php) * DM + h * 128 + ch * 8; pk[i] = *(const u32x4*)(Kg + go); pv[i] = *(const u32x4*)(Vg + go); } } while (0)
#define ATT_LOADQ(itx) do { ATT_DECODE(itx) \
        const size_t tq = tok0 + (size_t)(n * 128 + i0 + fr) * r + php; const bf16_t* qp = Qg + tq * DM + h * 128 + 8 * g; \
        _Pragma("unroll") for (int ks = 0; ks < 4; ++ks) qf[ks] = *(const bf16x8*)(qp + 32 * ks); } while (0)
    if (nit > 0) { ATT_LOADKV(ATT_ITEM(0)); ATT_LOADQ(ATT_ITEM(0)); }
    for (int ii = 0; ii < nit; ++ii) {
        const int it = ATT_ITEM(ii), itn = ATT_ITEM(ii + 1);
        ATT_DECODE(it)
        lds_barrier();
#pragma unroll
        for (int i = 0; i < 8; ++i) { const int idx = tid + 512 * i, row = idx >> 4, ch = idx & 15;
            *(LAS u32x4*)(Ks + row * RS + ch * 16) = pk[i]; *(LAS u32x4*)(Vs + row * VRS + ch * 16) = pv[i]; }
        lds_barrier();
        if (ii + 1 < nit) ATT_LOADKV(itn);
        const int ktlo = n > 0 ? 0 : ((128 - w0) >> 4);
        const int koffr = (i0 - w0) >> 4;
        float mx = -INFINITY, den = 0.f; f32x4 oacc[8];
        {
            const float c1 = 0.08838834764831845f * 1.4426950408889634f, sl2 = exp2f(-0.5f * (float)(h + 1)) * (float)r * 1.4426950408889634f;
            int lv = lane; asm volatile("" : "+v"(lv));
            const int e0 = (lv & 15) - 4 * (lv >> 4);
            float ae[4];
#pragma unroll
            for (int jj = 0; jj < 4; ++jj) ae[jj] = -sl2 * (float)(e0 - jj);
            f32x4 sacc[10];
            LAS unsigned char* kbase = Ks + (w0 + 16 * koffr + fr) * RS + 16 * g;
            bf16x8 kfb[2][4];
#pragma unroll
            for (int ks = 0; ks < 4; ++ks) kfb[0][ks] = *(const LAS bf16x8*)(kbase + 64 * ks);
            sacc[9] = (f32x4){0.f, 0.f, 0.f, 0.f};
#pragma unroll
            for (int i = 0; i < 9; ++i) {
                if (i + 1 < 9) {
#pragma unroll
                    for (int ks = 0; ks < 4; ++ks) kfb[(i + 1) & 1][ks] = *(const LAS bf16x8*)(kbase + 16 * (i + 1) * RS + 64 * ks); }
                f32x4 a = (f32x4){0.f, 0.f, 0.f, 0.f};
#pragma unroll
                for (int ks = 0; ks < 4; ++ks) a = mfma16(kfb[i & 1][ks], qf[ks], a);
                const float tc = (koffr + i < ktlo) ? -INFINITY : sl2 * (float)(16 * i - 128);
#pragma unroll
                for (int jj = 0; jj < 4; ++jj) { float sv = fmaf(a[jj], c1, ae[jj] + tc);
                    if (i == 0) sv = (e0 - jj <= 0) ? sv : -INFINITY;
                    if (i == 8) sv = (e0 - jj >= 0) ? sv : -INFINITY;
                    a[jj] = sv; mx = fmaxf(mx, sv); }
                sacc[i] = a;
                asm volatile("" ::: "memory"); }
            if (ii + 1 < nit) ATT_LOADQ(itn);
            mx = fmaxf(mx, __shfl_xor(mx, 16)); mx = fmaxf(mx, __shfl_xor(mx, 32));
#pragma unroll
            for (int i = 0; i < 9; ++i)
#pragma unroll
                for (int jj = 0; jj < 4; ++jj) { const float pe = __builtin_amdgcn_exp2f(sacc[i][jj] - mx); den += pe; sacc[i][jj] = pe; }
            den += __shfl_xor(den, 16); den += __shfl_xor(den, 32);
#pragma unroll
            for (int dt = 0; dt < 8; ++dt) oacc[dt] = (f32x4){0.f, 0.f, 0.f, 0.f};
            LAS unsigned char* vbase = Vs + (w0 + 16 * koffr + 4 * g + q4) * VRS + 8 * p4;
            bf16x8 vfb[2][2]; bf16x8 pf;
#pragma unroll
            for (int d = 0; d < 2; ++d) vfb[0][d] = tr8(vbase + 32 * d, vbase + 32 * d + 16 * VRS);
#pragma unroll
            for (int u = 0; u < 20; ++u) { const int ks2 = u >> 2, qtr = u & 3;
                if (u + 1 < 20) { const int k2n = (u + 1) >> 2, qn = (u + 1) & 3; LAS unsigned char* vb = vbase + 32 * k2n * VRS;
#pragma unroll
                    for (int d = 0; d < 2; ++d) vfb[(u + 1) & 1][d] = tr8(vb + 32 * (2 * qn + d), vb + 32 * (2 * qn + d) + (k2n == 4 ? 0 : 16 * VRS)); }
                if (qtr == 0) { u32x4 pw; pw.x = cvt_pk_bf16(sacc[2 * ks2][0], sacc[2 * ks2][1]); pw.y = cvt_pk_bf16(sacc[2 * ks2][2], sacc[2 * ks2][3]);
                    pw.z = cvt_pk_bf16(sacc[2 * ks2 + 1][0], sacc[2 * ks2 + 1][1]); pw.w = cvt_pk_bf16(sacc[2 * ks2 + 1][2], sacc[2 * ks2 + 1][3]);
                    pf = __builtin_bit_cast(bf16x8, pw); }
#pragma unroll
                for (int d = 0; d < 2; ++d) oacc[2 * qtr + d] = mfma16(vfb[u & 1][d], pf, oacc[2 * qtr + d]);
                asm volatile("" ::: "memory"); }
        }
        const float inv = 1.f / den;
        const size_t tqo = tok0 + (size_t)(n * 128 + i0 + fr) * r + php;
        bf16_t* op = slot(p, 4 + pat) + tqo * DM + h * 128 + 4 * g;
#pragma unroll
        for (int dt = 0; dt < 8; ++dt) { u32x2 w; w.x = cvt_pk_bf16(oacc[dt][0] * inv, oacc[dt][1] * inv); w.y = cvt_pk_bf16(oacc[dt][2] * inv, oacc[dt][3] * inv);
            *(u32x2*)(op + 16 * dt) = w; }
        if (g == 0) lse[(size_t)pat * M_TOK * 16 + tqo * 16 + h] = (mx + __log2f(den)) * 0.6931471805599453f;
    }
#undef ATT_LOADKV
#undef ATT_ITEM
#undef ATT_LOADQ
#undef ATT_DECODE
}

DI void ph_comb(const Ctx cx, const Params& p) {
    const bf16_t* O0 = slot(p, 4); const bf16_t* O1 = slot(p, 5); const bf16_t* O2 = slot(p, 6); const bf16_t* Z = slot(p, 3);
    bf16_t* AG = slot(p, 7);
    const float* lse = (const float*)(p.ws + WS_LSE);
    const size_t nth = (size_t)cx.nb * 512, total = (size_t)M_TOK * 256;
    for (size_t idx0 = (size_t)cx.bid * 512 + cx.tid; idx0 < total; idx0 += 2 * nth) {
        u32x4 a0[2], a1[2], a2[2], z[2]; float l0[2], l1[2], l2[2]; size_t o[2]; bool ok[2];
#pragma unroll
        for (int q = 0; q < 2; ++q) { const size_t idx = idx0 + q * nth; ok[q] = idx < total; const size_t ix = ok[q] ? idx : idx0;
            const size_t m = ix >> 8; const int c8 = (int)(ix & 255), h = c8 >> 4; o[q] = m * DM + c8 * 8;
            l0[q] = lse[m * 16 + h]; l1[q] = lse[(size_t)M_TOK * 16 + m * 16 + h]; l2[q] = lse[(size_t)2 * M_TOK * 16 + m * 16 + h];
            a0[q] = __builtin_nontemporal_load((const u32x4*)(O0 + o[q])); a1[q] = __builtin_nontemporal_load((const u32x4*)(O1 + o[q])); a2[q] = __builtin_nontemporal_load((const u32x4*)(O2 + o[q])); z[q] = __builtin_nontemporal_load((const u32x4*)(Z + o[q])); }
#pragma unroll
        for (int q = 0; q < 2; ++q) {
            const float mxl = fmaxf(l0[q], fmaxf(l1[q], l2[q]));
            float w0 = __expf(l0[q] - mxl), w1 = __expf(l1[q] - mxl), w2 = __expf(l2[q] - mxl);
            const float inv = 1.f / (w0 + w1 + w2); w0 *= inv; w1 *= inv; w2 *= inv;
            u32x4 res;
#pragma unroll
            for (int e2 = 0; e2 < 4; ++e2) {
                const float lo = (w0 * bf_lo(a0[q][e2]) + w1 * bf_lo(a1[q][e2]) + w2 * bf_lo(a2[q][e2])) * siluf_(bf_lo(z[q][e2]));
                const float hi = (w0 * bf_hi(a0[q][e2]) + w1 * bf_hi(a1[q][e2]) + w2 * bf_hi(a2[q][e2])) * siluf_(bf_hi(z[q][e2]));
                res[e2] = cvt_pk_bf16(lo, hi); }
            if (ok[q]) *(u32x4*)(AG + o[q]) = res; }
    }
}

DI void ph_conv(const Ctx cx, const Params& p) {
    const bf16_t* U = slot(p, 0); bf16_t* QK = slot(p, 4);
    const size_t nth = (size_t)cx.nb * 512;
    for (size_t idx = (size_t)cx.bid * 512 + cx.tid; idx < (size_t)(M_TOK / 8) * 256; idx += nth) {
        const int c8 = (int)(idx & 255); const size_t t0 = (idx >> 8) * 8; const bool first = (t0 & (SEQ - 1)) == 0;
        float w[4][8], bias[8];
#pragma unroll
        for (int j = 0; j < 4; ++j) { const f32x4 a = *(const f32x4*)(p.conv_w + j * DM + c8 * 8), b2 = *(const f32x4*)(p.conv_w + j * DM + c8 * 8 + 4);
            w[j][0] = a.x; w[j][1] = a.y; w[j][2] = a.z; w[j][3] = a.w; w[j][4] = b2.x; w[j][5] = b2.y; w[j][6] = b2.z; w[j][7] = b2.w; }
        { const f32x4 a = *(const f32x4*)(p.conv_b + c8 * 8), b2 = *(const f32x4*)(p.conv_b + c8 * 8 + 4);
          bias[0] = a.x; bias[1] = a.y; bias[2] = a.z; bias[3] = a.w; bias[4] = b2.x; bias[5] = b2.y; bias[6] = b2.z; bias[7] = b2.w; }
        float u[11][8];
#pragma unroll
        for (int t = 0; t < 11; ++t) { u32x4 raw = (u32x4){0u, 0u, 0u, 0u};
            if (t >= 3 || !first) raw = *(const u32x4*)(U + (t0 + t - 3) * DM + c8 * 8);
#pragma unroll
            for (int e = 0; e < 4; ++e) { u[t][2 * e] = bf_lo(raw[e]); u[t][2 * e + 1] = bf_hi(raw[e]); } }
        const float osc = c8 >= 128 ? 0.08838834764831845f : 1.f;
#pragma unroll
        for (int t = 0; t < 8; ++t) { float y[8];
#pragma unroll
            for (int e = 0; e < 8; ++e) { float a = bias[e];
#pragma unroll
                for (int j = 0; j < 4; ++j) a += w[j][e] * u[t + j][e];
                y[e] = siluf_(a) * osc; }
            u32x4 res; res.x = cvt_pk_bf16(y[0], y[1]); res.y = cvt_pk_bf16(y[2], y[3]); res.z = cvt_pk_bf16(y[4], y[5]); res.w = cvt_pk_bf16(y[6], y[7]);
            *(u32x4*)(QK + (t0 + t) * DM + c8 * 8) = res; }
    }
}

DI void ph_mlstm(const Ctx cx, const Params& p, LAS unsigned char* lds) {
    const bf16_t* QK = slot(p, 4); const bf16_t* Vg = slot(p, 1); bf16_t* Hb = slot(p, 5);
    const float* igp = (const float*)(p.ws + WS_GATES); const float* lfp = igp + M_TOK * 8;
    const int tid = cx.tid, wave = __builtin_amdgcn_readfirstlane(tid >> 6), lane = tid & 63, fr = lane & 15, g = lane >> 4, q4 = fr >> 2, p4 = fr & 3;
    constexpr int RS = 272, VS = 112, BUF = 56576, O_Q = 0, O_K = 17408, O_V = 34816, O_C = 41984, O_G = 55040;
    constexpr int O_TB = 2 * BUF;
    const int tt = wave >> 1, wb = wave & 1;
    const u32x4 zero4 = (u32x4){0u, 0u, 0u, 0u};
    for (int item = cx.bid; item < 256; item += cx.nb) {
        int bhi = item >> 3, dvs = item & 7;
        if (cx.nb == 256) { bhi = (item & 7) * 4 + (item >> 6); dvs = (item >> 3) & 7; }
        const int b = bhi >> 3, h = bhi & 7;
        const size_t tok0 = (size_t)b * SEQ;
        __syncthreads();
        if (tid < 256) { const int bsel = tid >> 7, row = (tid >> 1) & 63, hf = tid & 1;
            *(LAS u32x4*)(lds + bsel * BUF + O_V + row * VS + 64 + hf * 16) = hf ? zero4 : (u32x4){0x3F80u, 0u, 0u, 0u}; }
        for (int i = tid; i < 816; i += 512) *(LAS u32x4*)(lds + O_C + i * 16) = zero4;
        f32x4 C[3];
#pragma unroll
        for (int ct = 0; ct < 3; ++ct) C[ct] = (f32x4){0.f, 0.f, 0.f, 0.f};
        float m_st = 0.f;
        struct PFSet { u32x4 q[2], k[2], v; };
        PFSet s0, s1; s0.v = zero4; s1.v = zero4;
        float gi = 0.f, gl = 0.f;
        const int prow = tid >> 4, pch = tid & 15;
#define ML_PREFETCH(S, cc) do { const size_t tb = tok0 + (size_t)(cc) * 64; \
            S.q[0] = *(const u32x4*)(QK + (tb + prow) * DM + h * 128 + pch * 8); S.q[1] = *(const u32x4*)(QK + (tb + prow + 32) * DM + h * 128 + pch * 8); \
            S.k[0] = *(const u32x4*)(QK + (tb + prow) * DM + 1024 + h * 128 + pch * 8); S.k[1] = *(const u32x4*)(QK + (tb + prow + 32) * DM + 1024 + h * 128 + pch * 8); \
            if (tid < 256) S.v = *(const u32x4*)(Vg + (tb + (tid >> 2)) * DM + h * 256 + dvs * 32 + (tid & 3) * 8); \
            } while (0)
#define ML_STORE(S, bp) do { LAS unsigned char* bp_ = (bp); \
            *(LAS u32x4*)(bp_ + O_Q + prow * RS + pch * 16) = S.q[0]; *(LAS u32x4*)(bp_ + O_Q + (prow + 32) * RS + pch * 16) = S.q[1]; \
            *(LAS u32x4*)(bp_ + O_K + prow * RS + pch * 16) = S.k[0]; *(LAS u32x4*)(bp_ + O_K + (prow + 32) * RS + pch * 16) = S.k[1]; \
            if (tid < 256) *(LAS u32x4*)(bp_ + O_V + (tid >> 2) * VS + (tid & 3) * 16) = S.v; } while (0)
#define ML_GLOAD(cc) do { const size_t tb = tok0 + (size_t)(cc) * 64; gi = igp[(tb + lane) * 8 + h]; gl = lfp[(tb + lane) * 8 + h]; } while (0)
#define ML_SCAN(cc) do { LAS float* tb_ = (LAS float*)(lds + O_TB) + ((cc) & 15) * 192; float bcs = gl; \
            _Pragma("unroll") for (int o = 1; o < 64; o <<= 1) { const float t_ = __shfl_up(bcs, o); if (lane >= o) bcs += t_; } \
            const float uu = gi - bcs; float cmx = uu; \
            _Pragma("unroll") for (int o = 1; o < 64; o <<= 1) { const float t_ = __shfl_up(cmx, o); if (lane >= o) cmx = fmaxf(cmx, t_); } \
            tb_[lane] = uu; tb_[64 + lane] = cmx; tb_[128 + lane] = bcs; } while (0)
#define ML_GATES(cc, bp) do { if (wave == 0) { const LAS float* tb_ = (const LAS float*)(lds + O_TB) + ((cc) & 15) * 192; LAS float* ga_ = (LAS float*)((bp) + O_G); \
            const float uu = tb_[lane], cmx = tb_[64 + lane], bcs = tb_[128 + lane]; \
            const float cm = fmaxf(m_st, cmx), mt = bcs + cm; \
            const float b_last = __int_as_float(__builtin_amdgcn_readlane(__float_as_int(bcs), 63)), cm63 = __int_as_float(__builtin_amdgcn_readlane(__float_as_int(cm), 63)); \
            ga_[lane] = uu; ga_[64 + lane] = cm; ga_[128 + lane] = __expf(m_st - cm); ga_[192 + lane] = __expf(-mt); ga_[256 + lane] = __expf(uu - cm63); \
            if (lane == 0) ga_[320] = __expf(m_st - cm63); \
            m_st = b_last + cm63; } } while (0)
        ML_GLOAD(wave); ML_SCAN(wave); ML_GLOAD(8 + wave); ML_SCAN(8 + wave);
        __syncthreads();
        ML_PREFETCH(s0, 0); ML_PREFETCH(s1, 1);
        ML_STORE(s0, lds); ML_GATES(0, lds);
        ML_PREFETCH(s0, 2);
        __syncthreads();
        for (int c2 = 0; c2 < 64; c2 += 2) {
#pragma unroll
          for (int hc = 0; hc < 2; ++hc) {
            const int c = c2 + hc;
            LAS unsigned char* cur = lds + hc * BUF; LAS unsigned char* nxt = lds + (hc ^ 1) * BUF;
            if (hc == 0) { if (c + 1 < 64) { ML_STORE(s1, nxt); ML_GATES(c + 1, nxt); if (c + 3 < 64) ML_PREFETCH(s1, c + 3); } }
            else { if (c + 1 < 64) { ML_STORE(s0, nxt); ML_GATES(c + 1, nxt); if (c + 3 < 64) ML_PREFETCH(s0, c + 3); } }
            if (hc == 0) { if ((c & 7) == 0 && c + 16 + wave < 64) ML_GLOAD(c + 16 + wave); }
            else { if ((c & 7) == 7 && c + 9 + wave < 64) ML_SCAN(c + 9 + wave); }
            LAS unsigned char* qs = cur + O_Q; LAS unsigned char* ks = cur + O_K; LAS unsigned char* vs = cur + O_V; LAS unsigned char* cbs = cur + O_C;
            const LAS float* ga = (const LAS float*)(cur + O_G);
            const int t = 16 * tt + fr;
            const float cm_t = ga[64 + t], wi_t = ga[128 + t], emt_t = ga[192 + t];
            bf16x8 qf[4];
#pragma unroll
            for (int k4 = 0; k4 < 4; ++k4) qf[k4] = *(const LAS bf16x8*)(qs + t * RS + (32 * k4 + 8 * g) * 2);
            f32x4 sT[4];
#pragma unroll
            for (int st = 0; st < 4; ++st) { sT[st] = (f32x4){0.f, 0.f, 0.f, 0.f};
                if (st <= tt) {
#pragma unroll
                    for (int k4 = 0; k4 < 4; ++k4) { const bf16x8 kf = *(const LAS bf16x8*)(ks + (16 * st + fr) * RS + (32 * k4 + 8 * g) * 2); sT[st] = mfma16(kf, qf[k4], sT[st]); }
                    const f32x4 u4 = *(const LAS f32x4*)(ga + 16 * st + 4 * g);
#pragma unroll
                    for (int jj = 0; jj < 4; ++jj) { const int s = 16 * st + 4 * g + jj; sT[st][jj] *= (s <= t) ? __expf(u4[jj] - cm_t) : 0.f; } } }
            f32x4 nA = (f32x4){0.f, 0.f, 0.f, 0.f}, nD = nA, iA = nA, iD = nA;
#pragma unroll
            for (int k2 = 0; k2 < 2; ++k2) {
                if (2 * k2 <= tt) {
                    u32x4 sw; sw.x = cvt_pk_bf16(sT[2 * k2][0], sT[2 * k2][1]); sw.y = cvt_pk_bf16(sT[2 * k2][2], sT[2 * k2][3]);
                    sw.z = cvt_pk_bf16(sT[2 * k2 + 1][0], sT[2 * k2 + 1][1]); sw.w = cvt_pk_bf16(sT[2 * k2 + 1][2], sT[2 * k2 + 1][3]);
                    const bf16x8 scf = __builtin_bit_cast(bf16x8, sw);
                    LAS unsigned char* vb = vs + (32 * k2 + 4 * g + q4) * VS + 8 * p4;
                    const bf16x8 vA = tr8(vb + 32 * wb, vb + 32 * wb + 16 * VS);
                    const bf16x8 vD = tr8(vb + 64, vb + 64 + 16 * VS);
                    nA = mfma16(vA, scf, nA); nD = mfma16(vD, scf, nD); } }
#pragma unroll
            for (int k4 = 0; k4 < 4; ++k4) {
                const bf16x8 cA = *(const LAS bf16x8*)(cbs + (16 * wb + fr) * RS + (32 * k4 + 8 * g) * 2);
                const bf16x8 cD = *(const LAS bf16x8*)(cbs + (32 + fr) * RS + (32 * k4 + 8 * g) * 2);
                iA = mfma16(cA, qf[k4], iA); iD = mfma16(cD, qf[k4], iD); }
            {
                float den = wi_t * iD[0] + nD[0];
                den = __shfl(den, fr);
                const float dinv = 1.f / fmaxf(fabsf(den), emt_t);
                u32x2 w; w.x = cvt_pk_bf16((wi_t * iA[0] + nA[0]) * dinv, (wi_t * iA[1] + nA[1]) * dinv); w.y = cvt_pk_bf16((wi_t * iA[2] + nA[2]) * dinv, (wi_t * iA[3] + nA[3]) * dinv);
                *(u32x2*)(Hb + (tok0 + (size_t)c * 64 + t) * DM + h * 256 + dvs * 32 + 16 * wb + 4 * g) = w;
            }
            {
                const float w_old = ga[320];
#pragma unroll
                for (int ct = 0; ct < 3; ++ct) C[ct] *= w_old;
#pragma unroll
                for (int k2 = 0; k2 < 2; ++k2) {
                    LAS unsigned char* kb = ks + (32 * k2 + 8 * g + q4) * RS + (16 * wave + 4 * p4) * 2;
                    const bf16x8 kraw = tr8(kb, kb + 4 * RS);
                    const f32x4 w0 = *(const LAS f32x4*)(ga + 256 + 32 * k2 + 8 * g), w1 = *(const LAS f32x4*)(ga + 256 + 32 * k2 + 8 * g + 4);
                    u32x4 ka;
                    ka.x = cvt_pk_bf16(bf1((bf16_t)kraw[0]) * w0.x, bf1((bf16_t)kraw[1]) * w0.y); ka.y = cvt_pk_bf16(bf1((bf16_t)kraw[2]) * w0.z, bf1((bf16_t)kraw[3]) * w0.w);
                    ka.z = cvt_pk_bf16(bf1((bf16_t)kraw[4]) * w1.x, bf1((bf16_t)kraw[5]) * w1.y); ka.w = cvt_pk_bf16(bf1((bf16_t)kraw[6]) * w1.z, bf1((bf16_t)kraw[7]) * w1.w);
                    const bf16x8 kf = __builtin_bit_cast(bf16x8, ka);
                    LAS unsigned char* vb = vs + (32 * k2 + 8 * g + q4) * VS + 8 * p4;
#pragma unroll
                    for (int ct = 0; ct < 3; ++ct) { const bf16x8 vf = tr8(vb + 32 * ct, vb + 32 * ct + 4 * VS); C[ct] = mfma16(kf, vf, C[ct]); }
                }
#pragma unroll
                for (int ct = 0; ct < 3; ++ct) { u32x2 w; w.x = cvt_pk_bf16(C[ct][0], C[ct][1]); w.y = cvt_pk_bf16(C[ct][2], C[ct][3]);
                    *(LAS u32x2*)(nxt + O_C + (16 * ct + fr) * RS + (16 * wave + 4 * g) * 2) = w; }
            }
            lds_barrier();
          }
        }
#undef ML_PREFETCH
#undef ML_GLOAD
#undef ML_SCAN
#undef ML_GATES
#undef ML_STORE
    }
}

DI void ph_mnorm(const Ctx cx, const Params& p) {
    bf16_t* Hb = slot(p, 5); const bf16_t* MO = slot(p, 2); const bf16_t* MZ = slot(p, 3);
    const int wave = cx.tid >> 6, lane = cx.tid & 63;
    const int gw = cx.bid * 8 + wave, NGW = cx.nb * 8;
    u32x4 hn[4], on[4], zn[4];
#define MN_LOAD(r) do { _Pragma("unroll") for (int j = 0; j < 4; ++j) { const size_t o_ = (size_t)(r) * DM + 512 * j + 8 * lane; \
        hn[j] = __builtin_nontemporal_load((const u32x4*)(Hb + o_)); on[j] = __builtin_nontemporal_load((const u32x4*)(MO + o_)); zn[j] = __builtin_nontemporal_load((const u32x4*)(MZ + o_)); } } while (0)
    if (gw < M_TOK) MN_LOAD(gw);
    for (int row = gw; row < M_TOK; row += NGW) {
        u32x4 hq[4], oq[4], zq[4];
#pragma unroll
        for (int j = 0; j < 4; ++j) { hq[j] = hn[j]; oq[j] = on[j]; zq[j] = zn[j]; }
        if (row + NGW < M_TOK) MN_LOAD(row + NGW);
#pragma unroll
        for (int j = 0; j < 4; ++j) { const size_t o = (size_t)row * DM + 512 * j + 8 * lane;
            float cv[8]; float ss = 0.f;
#pragma unroll
            for (int e2 = 0; e2 < 4; ++e2) { cv[2 * e2] = sigmoidf_(bf_lo(oq[j][e2])) * bf_lo(hq[j][e2]); cv[2 * e2 + 1] = sigmoidf_(bf_hi(oq[j][e2])) * bf_hi(hq[j][e2]);
                ss += cv[2 * e2] * cv[2 * e2] + cv[2 * e2 + 1] * cv[2 * e2 + 1]; }
#pragma unroll
            for (int of = 1; of < 32; of <<= 1) ss += __shfl_xor(ss, of);
            const float rinv = rsqrtf(ss * (1.f / 256.f) + 1e-6f);
            const f32x4 g0 = *(const f32x4*)(p.mnorm_g + 512 * j + 8 * lane), g1 = *(const f32x4*)(p.mnorm_g + 512 * j + 8 * lane + 4);
            u32x4 res;
            res.x = cvt_pk_bf16(cv[0] * rinv * g0.x * siluf_(bf_lo(zq[j].x)), cv[1] * rinv * g0.y * siluf_(bf_hi(zq[j].x)));
            res.y = cvt_pk_bf16(cv[2] * rinv * g0.z * siluf_(bf_lo(zq[j].y)), cv[3] * rinv * g0.w * siluf_(bf_hi(zq[j].y)));
            res.z = cvt_pk_bf16(cv[4] * rinv * g1.x * siluf_(bf_lo(zq[j].z)), cv[5] * rinv * g1.y * siluf_(bf_hi(zq[j].z)));
            res.w = cvt_pk_bf16(cv[6] * rinv * g1.z * siluf_(bf_lo(zq[j].w)), cv[7] * rinv * g1.w * siluf_(bf_hi(zq[j].w)));
            *(u32x4*)(Hb + o) = res; }
    }
#undef MN_LOAD
}

DI void ph_fin(const Ctx cx, const Params& p) {
    const int wave = cx.tid >> 6, lane = cx.tid & 63;
    const int gw = cx.bid * 8 + wave, NGW = cx.nb * 8;
    const bf16_t* DL = slot(p, 3);
    f32x4 xn[8]; u32x2 dn[8];
#define FN_LOAD(r) do { const f32x4* xr_ = (const f32x4*)(p.x + (size_t)(r) * DM) + lane; const u32x2* dr_ = (const u32x2*)(DL + (size_t)(r) * DM) + lane; \
        _Pragma("unroll") for (int j = 0; j < 8; ++j) { xn[j] = __builtin_nontemporal_load(xr_ + 64 * j); dn[j] = __builtin_nontemporal_load(dr_ + 64 * j); } } while (0)
    if (gw < M_TOK) FN_LOAD(gw);
    for (int row = gw; row < M_TOK; row += NGW) {
        f32x4* orow = (f32x4*)(p.out + (size_t)row * DM) + lane;
        f32x4 v[8]; float s = 0.f;
#pragma unroll
        for (int j = 0; j < 8; ++j) { v[j] = xn[j]; v[j].x += bf_lo(dn[j].x); v[j].y += bf_hi(dn[j].x); v[j].z += bf_lo(dn[j].y); v[j].w += bf_hi(dn[j].y); }
        if (row + NGW < M_TOK) FN_LOAD(row + NGW);
#pragma unroll
        for (int j = 0; j < 8; ++j) s += (v[j].x * v[j].x + v[j].y * v[j].y) + (v[j].z * v[j].z + v[j].w * v[j].w);
        s = wave_sum(s);
        const float rstd = rsqrtf(s * (1.f / DM) + 1e-6f);
#pragma unroll
        for (int j = 0; j < 8; ++j) { const f32x4 g4 = ((const f32x4*)p.final_g)[64 * j + lane]; orow[64 * j] = (v[j] * rstd) * g4; }
    }
#undef FN_LOAD
}

__global__ void __launch_bounds__(512, 2) hybrid_block_fwd(Params p) {
    extern __shared__ __attribute__((aligned(16))) unsigned char shm[];
    LAS unsigned char* lds = (LAS unsigned char*)shm;
    cg::grid_group grid = cg::this_grid();
    if (threadIdx.x < 4) ((volatile LAS unsigned*)(lds + 143360))[threadIdx.x] = 0u;
    __syncthreads();
    if (blockIdx.x == 0) { unsigned* bw = (unsigned*)(p.ws + WS_BAR); for (int i = threadIdx.x; i < XCD_BAR_WORDS; i += 512) bw[i] = 0u; }
    XcdBarrier xb; xb.bar = (unsigned*)(p.ws + WS_BAR); xb.x = 0u; xb.st = (volatile LAS unsigned*)(lds + 143360);
    for (int ph = p.ph_lo; ph < p.ph_hi; ++ph) {
        if (ph == 8 || ph == 10) continue;
        if (ph > p.ph_lo) { if (ph == p.ph_lo + 1) { grid.sync(); xb = xcd_barrier_post((unsigned*)(p.ws + WS_BAR), (volatile LAS unsigned*)(lds + 143360)); } else xcd_barrier(xb); }
#ifdef EXTRA_SYNCS
        if (ph == 3) { for (int i = 0; i < EXTRA_SYNCS; ++i) grid.sync(); }
#endif
#ifndef ONLY_PHASE
#define ONLY_PHASE -1
#endif
#ifndef REPEAT_PHASE
#define REPEAT_PHASE -1
#endif
        for (int rep = 0; rep < (ph == REPEAT_PHASE ? 2 : 1); ++rep) {
        if (rep) { if (ph == p.ph_lo) grid.sync(); else xcd_barrier(xb); }
        Ctx cx; cx.tid = threadIdx.x; cx.bid = blockIdx.x; cx.nb = gridDim.x;
        asm volatile("" : "+v"(cx.tid)); asm volatile("" : "+s"(cx.bid)); asm volatile("" : "+s"(cx.nb));
#define PHEN(k) (ONLY_PHASE < 0 || ONLY_PHASE == (k))
        switch (ph) {
        case 0: if (PHEN(0)) ph_prep(cx, p, lds); break;
        case 1: case 4: if (PHEN(1)) {
            const int grp = ph == 1 ? 0 : 1;
            EpiSplitBf16T<true> E; E.O = slot(p, 0); E.seg_stride = SLOT / 2; E.O4 = slot(p, 6); E.O5 = (bf16_t*)p.out + (size_t)32 * 1024 * 1024;
            run_gemm(cx, lds, (const bf16_t*)p.out, (const bf16_t*)(p.ws + WS_WINT) + (size_t)grp * 8192 * DM, grp == 1 ? 12288 : 8192, DM, E);
        } break;
        case 2: if (PHEN(2)) ph_attn(cx, p, lds); break;
        case 3: if (PHEN(3)) ph_comb(cx, p); break;
        case 5: if (PHEN(5)) ph_conv(cx, p); break;
        case 6: if (PHEN(6)) ph_mlstm(cx, p, lds); break;
        case 7: if (PHEN(7)) ph_mnorm(cx, p); break;
        case 9: if (PHEN(9)) { EpiMerge2 E; E.ga = slot(p, 6); E.gm = (const bf16_t*)p.out + (size_t)32 * 1024 * 1024; E.O = slot(p, 2);
            run_gemm(cx, lds, slot(p, 7), (const bf16_t*)(p.ws + WS_WA), DM, DM, E, slot(p, 5), (const bf16_t*)(p.ws + WS_WM)); } break;
        case 11: if (PHEN(11)) { EpiSplitBf16T<false> E; E.O = slot(p, 3); E.seg_stride = 0; E.O4 = nullptr; E.O5 = nullptr;
            run_gemm(cx, lds, slot(p, 2), (const bf16_t*)(p.ws + WS_WO), DM, DM, E); } break;
        case 12: if (PHEN(12)) ph_fin(cx, p); break;
        default: break;
        }
        }
    }
}

extern "C" void kernel_launch(void* const* d_in, const int* in_sizes, int n_in, void* d_out, int out_size, void* d_ws, size_t ws_size, hipStream_t stream) {
    static int grid = 0;
    if (grid == 0) {
        int dev = 0, cus = 0, per_cu = 0;
        (void)hipGetDevice(&dev);
        (void)hipDeviceGetAttribute(&cus, hipDeviceAttributeMultiprocessorCount, dev);
        (void)hipFuncSetAttribute((const void*)hybrid_block_fwd, hipFuncAttributeMaxDynamicSharedMemorySize, LDS_BYTES);
        if (hipOccupancyMaxActiveBlocksPerMultiprocessor(&per_cu, (const void*)hybrid_block_fwd, 512, LDS_BYTES) != hipSuccess || per_cu < 1) { (void)hipGetLastError(); per_cu = 1; }
        if (per_cu > 1) per_cu = 1;
        grid = cus * per_cu;
        if (ws_size < WS_SLOT + 8 * SLOT) fprintf(stderr, "kernel_launch: workspace too small: %zu\n", ws_size);
    }
    Params p{};
    p.x = (const float*)d_in[0]; p.norm_g = (const float*)d_in[1]; p.w_in = (const float*)d_in[2]; p.b_if = (const float*)d_in[3];
    p.conv_w = (const float*)d_in[4]; p.conv_b = (const float*)d_in[5]; p.mnorm_g = (const float*)d_in[6]; p.w_attn = (const float*)d_in[7];
    p.w_mlstm = (const float*)d_in[8]; p.w_out = (const float*)d_in[9]; p.final_g = (const float*)d_in[10];
    p.out = (float*)d_out; p.ws = (unsigned char*)d_ws; p.ph_lo = 0; p.ph_hi = NPHASE;
    void* args[] = {&p};
    hipError_t e = hipLaunchCooperativeKernel((const void*)hybrid_block_fwd, dim3(grid), dim3(512), args, LDS_BYTES, stream);
    if (e != hipSuccess) fprintf(stderr, "cooperative launch failed: %s (grid %d)\n", hipGetErrorString(e), grid);
}
```

```cpp
#include <hip/hip_runtime.h>
#include <hip/hip_cooperative_groups.h>
#include <cstdio>
#include <type_traits>
namespace cg = cooperative_groups;
namespace pg8 {
#define PG8_LAS __attribute__((address_space(3)))
typedef unsigned short bf16_t;
typedef short bf16x8 __attribute__((ext_vector_type(8)));
typedef float f32x4 __attribute__((ext_vector_type(4)));
typedef unsigned u32x4 __attribute__((ext_vector_type(4)));
constexpr int BM = 256, BK = 64, HALF = 128, HTB = HALF * BK * 2  , STAGE_BYTES = 8 * HTB, NXCD = 8, WGM = 8;

__host__ __device__ __forceinline__ int lds_byte(int r, int c) { const int st = (r >> 4) * 2 + (c >> 5), rr = r & 15, cc = c & 31, ob = rr * 64 + cc * 2; return st * 1024 + (ob ^ (((ob >> 9) & 1) << 5)); }
__host__ __device__ __forceinline__ void stage_rc(int b, int& R, int& C) { const int st = b / 1024, sb = b % 1024, swz = sb ^ (((sb >> 9) & 1) << 5); R = (st >> 1) * 16 + swz / 64; C = (st & 1) * 32 + (swz % 64) / 2; }
__host__ __device__ __forceinline__ int perm32(int rho) { const int n = rho >> 4, i = rho & 15; return 8 * (i >> 2) + 4 * n + (i & 3); }

struct Unit { int pm, pn; };
struct Gemm { const bf16_t* A; const bf16_t* Bt; int M, N, K; const bf16_t* A2; const bf16_t* Bt2; };

struct StaticOrder {
    int nM, nN, nwg, G, c;
    __host__ __device__ void init(int M, int N, int G_, int c_) { nM = M / BM; nN = N / BM; nwg = nM * nN; G = G_; c = c_; }
    __host__ __device__ bool next(int i, Unit& u) const {
        const long L = (long)i * G + c; if (L >= nwg) return false;
        int wgid = (int)L; { const int q = nwg / NXCD, r = nwg % NXCD, xcd = wgid % NXCD, off = wgid / NXCD; wgid = (xcd < r ? xcd * (q + 1) : r * (q + 1) + (xcd - r) * q) + off; }
        const int nig = WGM * nN, gid = wgid / nig, fm = gid * WGM, gsz = (nM - fm) < WGM ? (nM - fm) : WGM;
        u.pm = fm + ((wgid % nig) % gsz); u.pn = (wgid % nig) / gsz; return true;
    }
    __device__ __forceinline__ void a_ready(const Unit&) const {}
    __device__ __forceinline__ void done(const Unit&) const {}
};
typedef __bf16 bf16x2v_t __attribute__((ext_vector_type(2)));
typedef float f32x2v_t __attribute__((ext_vector_type(2)));
__device__ __forceinline__ unsigned cvt_pk_bf16(float lo, float hi) { const f32x2v_t f = {lo, hi}; const bf16x2v_t b = __builtin_convertvector(f, bf16x2v_t); return __builtin_bit_cast(unsigned, b); }
typedef float f32x2 __attribute__((ext_vector_type(2)));
template <class Epi, class Sched, bool STAMP = false>
__device__ __forceinline__ void gemm_phase(PG8_LAS unsigned char* lds, const Gemm g, const Sched& S, const Epi& E, unsigned long long* stamps, const int tid_in) {
    const int tid = tid_in, wid = __builtin_amdgcn_readfirstlane(tid >> 6), lane = tid & 63, wr = wid >> 2, wc = wid & 3, fr = lane & 15, fq = lane >> 4;
    const int K = g.K, nth = K / BK, nt = g.A2 ? 2 * nth : nth;
    int ts_lo = 0, ts_hi = 0, nts = 0; const unsigned long long rt_entry = STAMP ? (unsigned long long)wall_clock64() : 0ull;
#define PG8_STAMP() do { if (STAMP && wid == 0 && nts < 64) { const unsigned long long _c = (unsigned long long)clock64(); \
        ts_lo = (lane == nts) ? (int)(unsigned)_c : ts_lo; ts_hi = (lane == nts) ? (int)(unsigned)(_c >> 32) : ts_hi; ++nts; } } while (0)
    PG8_STAMP();
    unsigned voffA[2], voffB[2];
#pragma unroll
    for (int i = 0; i < 2; ++i) { int R, C; stage_rc(tid * 16 + i * 8192, R, C); const int Rb = Epi::PERM ? ((R & ~31) + perm32(R & 31)) : R;
        voffA[i] = (unsigned)(R * K + C) * 2u; voffB[i] = (unsigned)(Rb * K + C) * 2u; }
    const size_t kstep = (size_t)(BK * 2);
    const size_t hstep = (size_t)HALF * K * 2;
    const size_t tstep = 2 * hstep;
    const unsigned ldsw = (unsigned)wid * 1024u;
    const int aoff = lds_byte(wr * 64 + fr, fq * 8), boff = lds_byte(wc * 32 + fr, fq * 8);
#define PG8_SA(b, h) (((b) * 2 + (h)) * HTB)
#define PG8_SB(b, h) ((4 + (b) * 2 + (h)) * HTB)
#define PG8_STAGE(bufoff, gbase, voff) do { _Pragma("unroll") for (int _i = 0; _i < 2; ++_i) \
        __builtin_amdgcn_global_load_lds((const unsigned*)((const char*)(gbase) + (voff)[_i]), (PG8_LAS unsigned*)(lds + (bufoff) + ldsw + _i * 8192), 16, 0, 0); } while (0)
#define PG8_LDA(dst, b, h) do { _Pragma("unroll") for (int m = 0; m < 4; ++m) _Pragma("unroll") for (int k = 0; k < 2; ++k) dst[m][k] = *(const PG8_LAS bf16x8*)(lds + PG8_SA(b, h) + aoff + m * 2048 + k * 1024); } while (0)
#define PG8_LDB(dst, b, h) do { _Pragma("unroll") for (int n = 0; n < 2; ++n) _Pragma("unroll") for (int k = 0; k < 2; ++k) dst[n][k] = *(const PG8_LAS bf16x8*)(lds + PG8_SB(b, h) + boff + n * 2048 + k * 1024); } while (0)
#define PG8_MMA(ai, bj, At, Bt) do { __builtin_amdgcn_s_setprio(1); _Pragma("unroll") for (int m = 0; m < 4; ++m) _Pragma("unroll") for (int n = 0; n < 2; ++n) _Pragma("unroll") for (int k = 0; k < 2; ++k) \
        acc[ai][bj][m][n] = __builtin_amdgcn_mfma_f32_16x16x32_bf16(Bt[n][k], At[m][k], acc[ai][bj][m][n], 0, 0, 0); __builtin_amdgcn_s_setprio(0); } while (0)
#define PG8_WAIT_V(n) asm volatile("s_waitcnt vmcnt(" #n ")" ::: "memory")
#define PG8_WAIT_L(n) asm volatile("s_waitcnt lgkmcnt(" #n ")" ::: "memory")
#define PG8_BAR __builtin_amdgcn_s_barrier()
#define PG8_SCHED __builtin_amdgcn_sched_barrier(0)
    Unit cur, nxt; int ui = 0;
    if (!S.next(0, cur)) return;
    f32x4 acc[2][2][4][2];
#pragma unroll
    for (int a = 0; a < 2; ++a)
#pragma unroll
        for (int b = 0; b < 2; ++b)
#pragma unroll
            for (int m = 0; m < 4; ++m)
#pragma unroll
                for (int n = 0; n < 2; ++n) acc[a][b][m][n] = (f32x4){0.f, 0.f, 0.f, 0.f};
    bf16x8 At[4][2], B0[2][2], B1[2][2];
    const char* cA = (const char*)g.A + (size_t)cur.pm * tstep; const char* cB = (const char*)g.Bt + (size_t)cur.pn * tstep;
    const char* cA2 = g.A2 ? (const char*)g.A2 + (size_t)cur.pm * tstep : cA; const char* cB2 = g.Bt2 ? (const char*)g.Bt2 + (size_t)cur.pn * tstep : cB;
#define PG8_KT(u1, u2, tix) ((tix) < nth ? (u1) + (size_t)(tix) * kstep : (u2) + (size_t)((tix) - nth) * kstep)
    S.a_ready(cur);
    PG8_STAGE(PG8_SB(0, 0), cB, voffB); PG8_STAGE(PG8_SA(0, 0), cA, voffA); PG8_STAGE(PG8_SB(0, 1), cB + hstep, voffB); PG8_STAGE(PG8_SA(0, 1), cA + hstep, voffA);
    if (wr == 1) PG8_BAR;
    PG8_WAIT_V(4); PG8_BAR;
    PG8_STAGE(PG8_SB(1, 0), cB + kstep, voffB); PG8_STAGE(PG8_SA(1, 0), cA + kstep, voffA); PG8_STAGE(PG8_SB(1, 1), cB + hstep + kstep, voffB);
    PG8_WAIT_V(6); PG8_BAR;
    PG8_STAMP();
    for (;;) {
        const bool has_next = S.next(ui + 1, nxt);
        const char* nA = has_next ? (const char*)g.A + (size_t)nxt.pm * tstep : cA; const char* nB = has_next ? (const char*)g.Bt + (size_t)nxt.pn * tstep : cB;
        for (int t = 0; t < nt; t += 2) {
            const bool last = (t == nt - 2);
            if constexpr (Epi::HAS_MID) { if (t == nth) { PG8_SCHED; E.mid(acc, cur, wr, wc, fr, fq); PG8_SCHED; } }
            const char* a1 = PG8_KT(cA, cA2, t + 1);
            const char* a2 = last ? nA : PG8_KT(cA, cA2, t + 2); const char* b2 = last ? nB : PG8_KT(cB, cB2, t + 2);
            const char* a3 = last ? nA + kstep : PG8_KT(cA, cA2, t + 3); const char* b3 = last ? nB + kstep : PG8_KT(cB, cB2, t + 3);
            if (last && has_next) S.a_ready(nxt);
            PG8_LDB(B0, 0, 0); PG8_SCHED; PG8_LDA(At, 0, 0); PG8_STAGE(PG8_SA(1, 1), a1 + hstep, voffA);
            PG8_WAIT_L(8); PG8_BAR; PG8_WAIT_L(0); PG8_MMA(0, 0, At, B0); PG8_BAR; PG8_SCHED;
            PG8_LDB(B1, 0, 1); PG8_STAGE(PG8_SB(0, 0), b2, voffB);
            PG8_BAR; PG8_WAIT_L(0); PG8_MMA(0, 1, At, B1); PG8_BAR;
            PG8_LDA(At, 0, 1); PG8_STAGE(PG8_SA(0, 0), a2, voffA);
            PG8_BAR; PG8_WAIT_L(0); PG8_MMA(1, 0, At, B0); PG8_BAR; PG8_SCHED;
            PG8_STAGE(PG8_SB(0, 1), b2 + hstep, voffB);
            PG8_WAIT_V(6); PG8_BAR; PG8_MMA(1, 1, At, B1); PG8_BAR;
            PG8_LDB(B0, 1, 0); PG8_SCHED; PG8_LDA(At, 1, 0); PG8_STAGE(PG8_SA(0, 1), a2 + hstep, voffA);
            PG8_WAIT_L(8); PG8_BAR; PG8_WAIT_L(0); PG8_MMA(0, 0, At, B0); PG8_BAR; PG8_SCHED;
            PG8_LDB(B1, 1, 1); PG8_STAGE(PG8_SB(1, 0), b3, voffB);
            PG8_BAR; PG8_WAIT_L(0); PG8_MMA(0, 1, At, B1); PG8_BAR;
            PG8_LDA(At, 1, 1); PG8_STAGE(PG8_SA(1, 0), a3, voffA);
            PG8_BAR; PG8_WAIT_L(0); PG8_MMA(1, 0, At, B0); PG8_BAR; PG8_SCHED;
            PG8_STAGE(PG8_SB(1, 1), b3 + hstep, voffB);
            PG8_WAIT_V(6); PG8_BAR; PG8_MMA(1, 1, At, B1); PG8_BAR;
        }
        PG8_STAMP();
        if constexpr (!Epi::AFTER_DRAIN) { E(acc, cur, wr, wc, fr, fq); S.done(cur); }
        PG8_STAMP();
        if (!has_next) break;
#pragma unroll
        for (int a = 0; a < 2; ++a)
#pragma unroll
            for (int b = 0; b < 2; ++b)
#pragma unroll
                for (int m = 0; m < 4; ++m)
#pragma unroll
                    for (int n = 0; n < 2; ++n) acc[a][b][m][n] = (f32x4){0.f, 0.f, 0.f, 0.f};
        cur = nxt; cA = nA; cB = nB; ++ui;
        cA2 = g.A2 ? (const char*)g.A2 + (size_t)cur.pm * tstep : cA; cB2 = g.Bt2 ? (const char*)g.Bt2 + (size_t)cur.pn * tstep : cB;
    }
    PG8_WAIT_V(0);
    if (wr == 0) PG8_BAR;
    PG8_BAR;
    if constexpr (Epi::AFTER_DRAIN) { E.fused(acc, cur, wr, wc, fr, fq, lds, wid, lane); S.done(cur); }
    PG8_STAMP();
    if (STAMP && wid == 0) { stamps[lane] = lane < nts ? (((unsigned long long)(unsigned)ts_hi << 32) | (unsigned)ts_lo) : 0ull;
        if (lane == 62) stamps[62] = rt_entry; if (lane == 63) stamps[63] = (unsigned long long)wall_clock64(); }
#undef PG8_STAMP
#undef PG8_SA
#undef PG8_SB
#undef PG8_STAGE
#undef PG8_LDA
#undef PG8_LDB
#undef PG8_MMA
#undef PG8_WAIT_V
#undef PG8_WAIT_L
#undef PG8_BAR
#undef PG8_SCHED
#undef PG8_KT
}
}


using pg8::bf16_t; using pg8::bf16x8; using pg8::f32x4; using pg8::u32x4; using pg8::cvt_pk_bf16;
typedef short s16x4 __attribute__((ext_vector_type(4)));
typedef unsigned u32x2 __attribute__((ext_vector_type(2)));
#define LAS __attribute__((address_space(3)))
#define DI __device__ __forceinline__
#define XB_TMO      128
#define XB_XCNT(j)  (256  + 64 * (j))
#define XB_XSUB(j)  (1280 + 64 * (j))
#define XB_XGEN(j)  (2304 + 64 * (j))
#define XB_TOP      3328
#define XB_TOPGEN   3392
#define XCD_BAR_WORDS 3456
#define XB_SPIN_CAP (1u << 22)

__device__ __forceinline__ unsigned xb_ld(unsigned* p)              { return __hip_atomic_load(p, __ATOMIC_RELAXED, __HIP_MEMORY_SCOPE_AGENT); }
__device__ __forceinline__ unsigned xb_add(unsigned* p, unsigned v) { return __hip_atomic_fetch_add(p, v, __ATOMIC_RELAXED, __HIP_MEMORY_SCOPE_AGENT); }
__device__ __forceinline__ unsigned xb_xcc_id() { return (unsigned)__builtin_amdgcn_s_getreg((3 << 11) | 20) & 0xFu; }
#define XB_SPIN(cond, bar) do { unsigned _sp = 0; while (cond) { __builtin_amdgcn_s_sleep(1); \
    if ((++_sp & 255u) == 0u) { if (xb_ld(&(bar)[XB_TMO])) break; if (_sp > XB_SPIN_CAP) { atomicAdd(&(bar)[XB_TMO], 1u); break; } } } } while (0)

struct XcdBarrier {
    unsigned* bar; unsigned x;
    volatile LAS unsigned* st;
};

__device__ __forceinline__ XcdBarrier xcd_barrier_post(unsigned* bar, volatile LAS unsigned* st) {
    XcdBarrier b; b.bar = bar; b.x = xb_xcc_id(); b.st = st;
    if (threadIdx.x == 0) (void)xb_add(&bar[XB_XCNT(b.x)], 1u);
    return b;
}
__device__ __forceinline__ void xcd_barrier_complete(unsigned* bar, unsigned x, unsigned& nloc, unsigned& nx) {
    const unsigned G = gridDim.x * gridDim.y * gridDim.z;
    unsigned sum, cnt, mine, sp = 0u;
    for (;;) {
        sum = 0u; cnt = 0u; mine = 0u;
#pragma unroll
        for (unsigned j = 0; j < 16; ++j) { const unsigned c = xb_ld(&bar[XB_XCNT(j)]); sum += c; cnt += (c > 0u) ? 1u : 0u; mine = (j == x) ? c : mine; }
        if (sum == G) break;
        __builtin_amdgcn_s_sleep(1);
        if ((++sp & 255u) == 0u) { if (xb_ld(&bar[XB_TMO])) break; if (sp > XB_SPIN_CAP) { atomicAdd(&bar[XB_TMO], 1u); break; } }
    }
    nloc = mine > 0u ? mine : 1u; nx = cnt > 0u ? cnt : 1u;
}

__device__ __forceinline__ void xcd_barrier(const XcdBarrier& b) {
    asm volatile("s_waitcnt vmcnt(0)" ::: "memory");
    __syncthreads();
    if (threadIdx.x == 0) {
        unsigned* bar = b.bar;
        __builtin_amdgcn_s_waitcnt(0);
        unsigned nloc = b.st[0], nx = b.st[1];
        if (nloc == 0u) { xcd_barrier_complete(bar, b.x, nloc, nx); b.st[0] = nloc; b.st[1] = nx; }
        const unsigned old = xb_add(&bar[XB_XSUB(b.x)], 1u);
        const unsigned gen = old / nloc;
        if (old + 1u == (gen + 1u) * nloc) {
            __builtin_amdgcn_fence(__ATOMIC_RELEASE, "agent");
            asm volatile("s_waitcnt vmcnt(0)" ::: "memory");
            const unsigned og = xb_add(&bar[XB_TOP], 1u);
            const unsigned tg = og / nx;
            if (og + 1u == (tg + 1u) * nx) xb_add(&bar[XB_TOPGEN], 1u);
            else XB_SPIN(xb_ld(&bar[XB_TOPGEN]) == tg, bar);
            __builtin_amdgcn_fence(__ATOMIC_ACQUIRE, "agent");
            xb_add(&bar[XB_XGEN(b.x)], 1u);
            asm volatile("s_waitcnt vmcnt(0)" ::: "memory");
        } else {
            XB_SPIN(xb_ld(&bar[XB_XGEN(b.x)]) == gen, bar);
            __builtin_amdgcn_fence(__ATOMIC_ACQUIRE, "agent");
            asm volatile("s_waitcnt vmcnt(0)" ::: "memory");
        }
    }
    __syncthreads();
}


constexpr int M_TOK = 16384, DM = 2048, SEQ = 4096, INW = 20496;
constexpr size_t MiB = (size_t)1 << 20;
constexpr size_t WS_WINT = 0, WS_WA = 80 * MiB, WS_WM = 88 * MiB, WS_WO = 96 * MiB, WS_GATES = 104 * MiB, WS_LSE = 105 * MiB, WS_BAR = 108 * MiB, WS_SLOT = 112 * MiB, SLOT = 64 * MiB;
constexpr int LDS_BYTES = 143360 + 16;
constexpr int NPHASE = 13;

struct Params {
    const float *x, *norm_g, *w_in, *b_if, *conv_w, *conv_b, *mnorm_g, *w_attn, *w_mlstm, *w_out, *final_g;
    float* out; unsigned char* ws; int ph_lo, ph_hi;
};

struct Ctx { int tid, bid, nb; };
DI void lds_barrier() { asm volatile("s_waitcnt lgkmcnt(0)" ::: "memory"); __builtin_amdgcn_s_barrier(); asm volatile("" ::: "memory"); }
DI float bf_lo(unsigned u) { return __uint_as_float(u << 16); }
DI float bf_hi(unsigned u) { return __uint_as_float(u & 0xffff0000u); }
DI float bf1(bf16_t b) { return __uint_as_float(((unsigned)b) << 16); }
DI bf16_t f2bf(float f) { return (bf16_t)(cvt_pk_bf16(f, 0.f) & 0xffffu); }
DI float sigmoidf_(float z) { return __builtin_amdgcn_rcpf(1.f + __expf(-z)); }
DI float siluf_(float z) { return z * sigmoidf_(z); }
DI float wave_sum(float v) {
#pragma unroll
    for (int o = 1; o < 64; o <<= 1) v += __shfl_xor(v, o);
    return v;
}
DI bf16_t* slot(const Params& p, int i) { return (bf16_t*)(p.ws + WS_SLOT + (size_t)i * SLOT); }
DI f32x4 mfma16(bf16x8 a, bf16x8 b, f32x4 c) { return __builtin_amdgcn_mfma_f32_16x16x32_bf16(a, b, c, 0, 0, 0); }
DI bf16x8 tr8(LAS unsigned char* lo, LAS unsigned char* hi) {
    s16x4 a = __builtin_amdgcn_ds_read_tr16_b64_v4i16((LAS s16x4*)lo);
    s16x4 b = __builtin_amdgcn_ds_read_tr16_b64_v4i16((LAS s16x4*)hi);
    return __builtin_shufflevector(a, b, 0, 1, 2, 3, 4, 5, 6, 7);
}

template <bool NT> struct EpiSplitBf16T {
    static constexpr bool PERM = true, AFTER_DRAIN = false, HAS_MID = false;
    bf16_t* O; size_t seg_stride; bf16_t* O4; bf16_t* O5;
    DI void operator()(const f32x4 (&acc)[2][2][4][2], const pg8::Unit& u, int wr, int wc, int fr, int fq) const {
        const int row0 = u.pm * 256 + wr * 64 + fr; int colt = u.pn * 256; const int seg = colt >> 11; colt &= 2047;
        bf16_t* base = seg < 4 ? O + (size_t)seg * seg_stride : (seg == 4 ? O4 : O5); const int col0 = colt + wc * 32 + 8 * fq;
#pragma unroll
        for (int ai = 0; ai < 2; ++ai)
#pragma unroll
            for (int m = 0; m < 4; ++m) { bf16_t* rowp = base + (size_t)(row0 + ai * 128 + m * 16) * DM + col0;
#pragma unroll
                for (int bj = 0; bj < 2; ++bj) { const f32x4 v0 = acc[ai][bj][m][0], v1 = acc[ai][bj][m][1];
                    u32x4 w; w.x = cvt_pk_bf16(v0[0], v0[1]); w.y = cvt_pk_bf16(v0[2], v0[3]); w.z = cvt_pk_bf16(v1[0], v1[1]); w.w = cvt_pk_bf16(v1[2], v1[3]);
                    if (NT) __builtin_nontemporal_store(w, (u32x4*)(rowp + bj * 128)); else *(u32x4*)(rowp + bj * 128) = w; } }
    }
};
template <int MODE> struct EpiGate {
    static constexpr bool PERM = true, AFTER_DRAIN = false, HAS_MID = false;
    const bf16_t* gate; float* T; bf16_t* O;
    DI void operator()(const f32x4 (&acc)[2][2][4][2], const pg8::Unit& u, int wr, int wc, int fr, int fq) const {
        const int row0 = u.pm * 256 + wr * 64 + fr, col0 = u.pn * 256 + wc * 32 + 8 * fq;
#pragma unroll
        for (int ai = 0; ai < 2; ++ai)
#pragma unroll
            for (int m = 0; m < 4; ++m) { const size_t ro = (size_t)(row0 + ai * 128 + m * 16) * DM + col0;
#pragma unroll
                for (int bj = 0; bj < 2; ++bj) { const size_t o = ro + bj * 128;
                    const u32x4 gq = *(const u32x4*)(gate + o);
                    f32x4 v0 = acc[ai][bj][m][0], v1 = acc[ai][bj][m][1];
                    v0[0] *= sigmoidf_(bf_lo(gq.x)); v0[1] *= sigmoidf_(bf_hi(gq.x)); v0[2] *= sigmoidf_(bf_lo(gq.y)); v0[3] *= sigmoidf_(bf_hi(gq.y));
                    v1[0] *= sigmoidf_(bf_lo(gq.z)); v1[1] *= sigmoidf_(bf_hi(gq.z)); v1[2] *= sigmoidf_(bf_lo(gq.w)); v1[3] *= sigmoidf_(bf_hi(gq.w));
                    if (MODE == 0) { *(f32x4*)(T + o) = v0; *(f32x4*)(T + o + 4) = v1; }
                    else { v0 += *(const f32x4*)(T + o); v1 += *(const f32x4*)(T + o + 4);
                        u32x4 w; w.x = cvt_pk_bf16(v0[0], v0[1]); w.y = cvt_pk_bf16(v0[2], v0[3]); w.z = cvt_pk_bf16(v1[0], v1[1]); w.w = cvt_pk_bf16(v1[2], v1[3]);
                        *(u32x4*)(O + o) = w; } } }
    }
};
struct EpiResid {
    static constexpr bool PERM = false, AFTER_DRAIN = false, HAS_MID = false;
    const float* x; float* out;
    DI void operator()(const f32x4 (&acc)[2][2][4][2], const pg8::Unit& u, int wr, int wc, int fr, int fq) const {
        const int row0 = u.pm * 256 + wr * 64 + fr, col0 = u.pn * 256 + wc * 32 + 4 * fq;
#pragma unroll
        for (int ai = 0; ai < 2; ++ai)
#pragma unroll
            for (int m = 0; m < 4; ++m) { const size_t ro = (size_t)(row0 + ai * 128 + m * 16) * DM + col0;
#pragma unroll
                for (int bj = 0; bj < 2; ++bj)
#pragma unroll
                    for (int n = 0; n < 2; ++n) { const size_t o = ro + bj * 128 + n * 16; *(f32x4*)(out + o) = acc[ai][bj][m][n] + *(const f32x4*)(x + o); } }
    }
};
struct EpiMerge2 {
    static constexpr bool PERM = true, AFTER_DRAIN = false, HAS_MID = true;
    const bf16_t* ga; const bf16_t* gm; bf16_t* O;
    DI void mid(f32x4 (&acc)[2][2][4][2], const pg8::Unit& u, int wr, int wc, int fr_, int fq) const {
        int fr = fr_; asm volatile("" : "+v"(fr));
        const int row0 = u.pm * 256 + wr * 64 + fr, col0 = u.pn * 256 + wc * 32 + 8 * fq;
#pragma unroll
        for (int ai = 0; ai < 2; ++ai)
#pragma unroll
            for (int m = 0; m < 4; ++m) { const size_t ro = (size_t)(row0 + ai * 128 + m * 16) * DM + col0;
#pragma unroll
                for (int bj = 0; bj < 2; ++bj) { const size_t o = ro + bj * 128;
                    const u32x4 aq = *(const u32x4*)(ga + o), mq = *(const u32x4*)(gm + o);
#pragma unroll
                    for (int e = 0; e < 4; ++e) {
                        const float rl = (1.f + __expf(-bf_lo(mq[e]))) * __builtin_amdgcn_rcpf(1.f + __expf(-bf_lo(aq[e])));
                        const float rh = (1.f + __expf(-bf_hi(mq[e]))) * __builtin_amdgcn_rcpf(1.f + __expf(-bf_hi(aq[e])));
                        acc[ai][bj][m][e >> 1][(2 * e) & 3] *= rl; acc[ai][bj][m][e >> 1][((2 * e) & 3) + 1] *= rh; } }
                asm volatile("" ::: "memory"); }
    }
    DI void operator()(const f32x4 (&acc)[2][2][4][2], const pg8::Unit& u, int wr, int wc, int fr_, int fq) const {
        int fr = fr_; asm volatile("" : "+v"(fr));
        const int row0 = u.pm * 256 + wr * 64 + fr, col0 = u.pn * 256 + wc * 32 + 8 * fq;
#pragma unroll
        for (int ai = 0; ai < 2; ++ai)
#pragma unroll
            for (int m = 0; m < 4; ++m) { const size_t ro = (size_t)(row0 + ai * 128 + m * 16) * DM + col0;
#pragma unroll
                for (int bj = 0; bj < 2; ++bj) { const size_t o = ro + bj * 128;
                    const u32x4 gq = *(const u32x4*)(gm + o);
                    const f32x4 v0 = acc[ai][bj][m][0], v1 = acc[ai][bj][m][1];
                    u32x4 w; w.x = cvt_pk_bf16(v0[0] * sigmoidf_(bf_lo(gq.x)), v0[1] * sigmoidf_(bf_hi(gq.x))); w.y = cvt_pk_bf16(v0[2] * sigmoidf_(bf_lo(gq.y)), v0[3] * sigmoidf_(bf_hi(gq.y)));
                    w.z = cvt_pk_bf16(v1[0] * sigmoidf_(bf_lo(gq.z)), v1[1] * sigmoidf_(bf_hi(gq.z))); w.w = cvt_pk_bf16(v1[2] * sigmoidf_(bf_lo(gq.w)), v1[3] * sigmoidf_(bf_hi(gq.w)));
                    *(u32x4*)(O + o) = w; } }
    }
};
template <class Epi> DI void run_gemm(const Ctx cx, LAS unsigned char* lds, const bf16_t* A, const bf16_t* Bt, int N, int K, const Epi& E, const bf16_t* A2 = nullptr, const bf16_t* Bt2 = nullptr) {
    pg8::Gemm g; g.A = A; g.Bt = Bt; g.M = M_TOK; g.N = N; g.K = K; g.A2 = A2; g.Bt2 = Bt2;
    pg8::StaticOrder S; S.init(M_TOK, N, cx.nb, cx.bid);
    pg8::gemm_phase<Epi, pg8::StaticOrder, false>(lds, g, S, E, nullptr, cx.tid);
}

DI void transpose_item(const float* W, int ldw, int sc0, bf16_t* WT, int dr0, int kb, LAS float* scr, int lane) {
    const int k0 = 64 * kb;
    float t[64];
#pragma unroll
    for (int i = 0; i < 64; ++i) t[i] = __builtin_nontemporal_load(W + (size_t)(k0 + i) * ldw + sc0 + lane);
#pragma unroll
    for (int i = 0; i < 64; ++i) scr[i * 65 + lane] = t[i];
    asm volatile("s_waitcnt lgkmcnt(0)" ::: "memory");
    const int c = lane & 7;
#pragma unroll
    for (int j = 0; j < 8; ++j) { const int n = (lane >> 3) + 8 * j; const LAS float* s = scr + (8 * c) * 65 + n;
        u32x4 o; o.x = cvt_pk_bf16(s[0 * 65], s[1 * 65]); o.y = cvt_pk_bf16(s[2 * 65], s[3 * 65]); o.z = cvt_pk_bf16(s[4 * 65], s[5 * 65]); o.w = cvt_pk_bf16(s[6 * 65], s[7 * 65]);
        *(u32x4*)(WT + (size_t)(dr0 + n) * DM + k0 + 8 * c) = o; }
    asm volatile("s_waitcnt lgkmcnt(0)" ::: "memory");
}
DI float reduce16_cols(const f32x4 (&a)[4], int lane) {
    float t8[8];
#pragma unroll
    for (int c = 0; c < 8; ++c) { const float lo = a[c >> 2][c & 3], hi = a[(c + 8) >> 2][c & 3]; const bool up = (lane & 32) != 0;
        const float keep = up ? hi : lo, give = up ? lo : hi; t8[c] = keep + __shfl_xor(give, 32); }
    float t4[4];
#pragma unroll
    for (int c = 0; c < 4; ++c) { const bool up = (lane & 16) != 0; const float keep = up ? t8[c + 4] : t8[c], give = up ? t8[c] : t8[c + 4]; t4[c] = keep + __shfl_xor(give, 16); }
    float t2[2];
#pragma unroll
    for (int c = 0; c < 2; ++c) { const bool up = (lane & 8) != 0; const float keep = up ? t4[c + 2] : t4[c], give = up ? t4[c] : t4[c + 2]; t2[c] = keep + __shfl_xor(give, 8); }
    const bool up = (lane & 4) != 0; const float keep = up ? t2[1] : t2[0], give = up ? t2[0] : t2[1];
    float t1 = keep + __shfl_xor(give, 4);
    t1 += __shfl_xor(t1, 2); t1 += __shfl_xor(t1, 1);
    return t1;
}
DI void ph_prep(const Ctx cx, const Params& p, LAS unsigned char* lds) {
    const int tid = cx.tid, wave = tid >> 6, lane = tid & 63;
    const int gw = cx.bid * 8 + wave, NGW = cx.nb * 8;
    constexpr int PREP_RB = 5;
    const bool split = cx.nb == 256; const int xcd_ = cx.bid & 7, jb = cx.bid >> 3, grp8 = xcd_ * 4 + (jb >> 3), r8 = jb & 7;
    const bool do_rows = !split || r8 < PREP_RB, do_tr = !split || r8 >= PREP_RB;
    const int gwr = split ? (grp8 * PREP_RB + r8) * 8 + wave : gw, NGWR = split ? 32 * PREP_RB * 8 : NGW;
    const int NGWT = split ? 32 * (8 - PREP_RB) * 8 : NGW;
    bf16_t* hn = (bf16_t*)p.out;
    float* ig = (float*)(p.ws + WS_GATES); float* lf = ig + M_TOK * 8;
    if (do_rows) {
    f32x4 na[8], nb2[8];
#define PR_LOAD(pr_) do { const f32x4* xr_ = (const f32x4*)(p.x + (size_t)(2 * (pr_)) * DM) + lane; \
        _Pragma("unroll") for (int j = 0; j < 8; ++j) { na[j] = __builtin_nontemporal_load(xr_ + 64 * j); nb2[j] = __builtin_nontemporal_load(xr_ + 512 + 64 * j); } } while (0)
    if (gwr < M_TOK / 2) PR_LOAD(gwr);
#pragma unroll
    for (int i = 0; i < 16; ++i) { const int idx = tid + 512 * i, l = idx & 63, rest = idx >> 6, c4 = rest & 3, e = (rest >> 2) & 3, j = rest >> 4;
        *(LAS f32x4*)(lds + (size_t)idx * 16) = *(const f32x4*)(p.w_in + (size_t)(256 * j + 4 * l + e) * INW + 12288 + 4 * c4); }
    __syncthreads();
    for (int pr = gwr; pr < M_TOK / 2; pr += NGWR) {
        const int row = 2 * pr;
        f32x4 va[8], vb[8]; float sa = 0.f, sb = 0.f;
#pragma unroll
        for (int j = 0; j < 8; ++j) { va[j] = na[j]; vb[j] = nb2[j]; }
        const int prn = (pr + NGWR < M_TOK / 2) ? pr + NGWR : pr;
        const f32x4* xrn = (const f32x4*)(p.x + (size_t)(2 * prn) * DM) + lane;
#pragma unroll
        for (int j = 0; j < 8; ++j) { sa += (va[j].x * va[j].x + va[j].y * va[j].y) + (va[j].z * va[j].z + va[j].w * va[j].w);
            sb += (vb[j].x * vb[j].x + vb[j].y * vb[j].y) + (vb[j].z * vb[j].z + vb[j].w * vb[j].w); }
        sa = wave_sum(sa); sb = wave_sum(sb);
        const float rstda = rsqrtf(sa * (1.f / DM) + 1e-6f), rstdb = rsqrtf(sb * (1.f / DM) + 1e-6f);
        f32x4 acca[4], accb[4];
#pragma unroll
        for (int c = 0; c < 4; ++c) { acca[c] = (f32x4){0.f, 0.f, 0.f, 0.f}; accb[c] = (f32x4){0.f, 0.f, 0.f, 0.f}; }
#pragma unroll
        for (int j = 0; j < 8; ++j) {
            const f32x4 g4 = ((const f32x4*)p.norm_g)[64 * j + lane];
            const f32x4 ha = (va[j] * rstda) * g4, hb = (vb[j] * rstdb) * g4;
            na[j] = __builtin_nontemporal_load(xrn + 64 * j); nb2[j] = __builtin_nontemporal_load(xrn + 512 + 64 * j);
            u32x2 pk; pk.x = cvt_pk_bf16(ha.x, ha.y); pk.y = cvt_pk_bf16(ha.z, ha.w);
            *(u32x2*)(hn + (size_t)row * DM + 256 * j + 4 * lane) = pk;
            pk.x = cvt_pk_bf16(hb.x, hb.y); pk.y = cvt_pk_bf16(hb.z, hb.w);
            *(u32x2*)(hn + (size_t)(row + 1) * DM + 256 * j + 4 * lane) = pk;
#pragma unroll
            for (int e = 0; e < 4; ++e) {
#pragma unroll
                for (int c4 = 0; c4 < 4; ++c4) { const f32x4 w = *(const LAS f32x4*)(lds + (size_t)((((j * 4 + e) * 4 + c4) * 64) + lane) * 16);
                    acca[c4] += ha[e] * w; accb[c4] += hb[e] * w; }
                if (e & 1) asm volatile("" ::: "memory"); }
        }
        const float suma = reduce16_cols(acca, lane), sumb = reduce16_cols(accb, lane);
        if ((lane & 3) == 0) { const int col = ((lane >> 5) & 1) * 8 + ((lane >> 4) & 1) * 4 + ((lane >> 3) & 1) * 2 + ((lane >> 2) & 1);
            const float za = suma + p.b_if[col], zb = sumb + p.b_if[col];
            if (col < 8) { ig[(size_t)row * 8 + col] = za; ig[(size_t)(row + 1) * 8 + col] = zb; }
            else { lf[(size_t)row * 8 + col - 8] = fminf(za, 0.f) - log1pf(__expf(-fabsf(za))); lf[(size_t)(row + 1) * 8 + col - 8] = fminf(zb, 0.f) - log1pf(__expf(-fabsf(zb))); } }
    }
#undef PR_LOAD
    }
    __syncthreads();
    if (do_tr) {
    int lane_t = lane, wave_t = wave; asm volatile("" : "+v"(lane_t), "+v"(wave_t));
    LAS float* scr = (LAS float*)(lds + wave_t * 16640);
    constexpr int I_IN = 32 * 320, I_SQ = 32 * 32, NIT = I_IN + 3 * I_SQ;
    const int gwt = split ? (grp8 * (8 - PREP_RB) + (r8 - PREP_RB)) * 8 + wave_t : cx.bid * 8 + wave_t;
    for (int it = gwt; it < NIT; it += NGWT) {
        if (it < I_IN) { const int kb = it / 320, nb = it % 320, n0 = 64 * nb;
            transpose_item(p.w_in, INW, n0 < 12288 ? n0 : n0 + 16, (bf16_t*)(p.ws + WS_WINT), n0, kb, scr, lane_t); }
        else { int r = it - I_IN; const int which = r / I_SQ; r -= which * I_SQ; const int kb = r >> 5, nb = r & 31;
            const float* W = which == 0 ? p.w_attn : (which == 1 ? p.w_mlstm : p.w_out);
            bf16_t* WT = (bf16_t*)(p.ws + (which == 0 ? WS_WA : (which == 1 ? WS_WM : WS_WO)));
            transpose_item(W, DM, 64 * nb, WT, 64 * nb, kb, scr, lane_t); }
    }
    }
}

DI void ph_attn(const Ctx cx, const Params& p, LAS unsigned char* lds) {
    const bf16_t* Qg = slot(p, 0); const bf16_t* Kg = slot(p, 1); const bf16_t* Vg = slot(p, 2);
    float* lse = (float*)(p.ws + WS_LSE);
    const int tid = cx.tid, wave = __builtin_amdgcn_readfirstlane(tid >> 6), lane = tid & 63, fr = lane & 15, g = lane >> 4, q4 = fr >> 2, p4 = fr & 3;
    constexpr int RS = 272, VRS = 288;
    LAS unsigned char* Ks = lds; LAS unsigned char* Vs = lds + 256 * RS;
    const int i0 = wave * 16, w0 = i0 < 96 ? i0 : 96;
    u32x4 pk[8], pv[8]; bf16x8 qf[4];
    const bool fast = cx.nb == 256; const int xcd = cx.bid & 7, cuix = cx.bid >> 3, nit = fast ? 24 : (6144 - cx.bid + cx.nb - 1) / cx.nb;
#define ATT_ITEM(i) (fast ? (((((xcd * 8 + (i) / 3) * 3 + (i) % 3)) << 5) | ((cuix + (i)) & 31)) : cx.bid + (i) * cx.nb)
#define ATT_DECODE(itx) const int blk = (itx) & 31, rest = (itx) >> 5, pat = rest % 3, bh = rest / 3, h = bh & 15, b = bh >> 4; \
        const int sh = 2 * pat, r = 1 << sh, nblk = 32 >> sh, php = blk >> (5 - sh), n = blk & (nblk - 1); const size_t tok0 = (size_t)b * SEQ;
#define ATT_LOADKV(itx) do { ATT_DECODE(itx) \
        _Pragma("unroll") for (int i = 0; i < 8; ++i) { const int idx = tid + 512 * i, row = idx >> 4, ch = idx & 15; int uu = (n - 1) * 128 + row; uu = uu < 0 ? 0 : uu; \
            const size_t go = (tok0 + (size_t)uu * r + php) * DM + h * 128 + ch * 8; pk[i] = *(const u32x4*)(Kg + go); pv[i] = *(const u32x4*)(Vg + go); } } while (0)
#define ATT_LOADQ(itx) do { ATT_DECODE(itx) \
        const size_t tq = tok0 + (size_t)(n * 128 + i0 + fr) * r + php; const bf16_t* qp = Qg + tq * DM + h * 128 + 8 * g; \
        _Pragma("unroll") for (int ks = 0; ks < 4; ++ks) qf[ks] = *(const bf16x8*)(qp + 32 * ks); } while (0)
    if (nit > 0) { ATT_LOADKV(ATT_ITEM(0)); ATT_LOADQ(ATT_ITEM(0)); }
    for (int ii = 0; ii < nit; ++ii) {
        const int it = ATT_ITEM(ii), itn = ATT_ITEM(ii + 1);
        ATT_DECODE(it)
        lds_barrier();
#pragma unroll
        for (int i = 0; i < 8; ++i) { const int idx = tid + 512 * i, row = idx >> 4, ch = idx & 15;
            *(LAS u32x4*)(Ks + row * RS + ch * 16) = pk[i]; *(LAS u32x4*)(Vs + row * VRS + ch * 16) = pv[i]; }
        lds_barrier();
        if (ii + 1 < nit) ATT_LOADKV(itn);
        const int ktlo = n > 0 ? 0 : ((128 - w0) >> 4);
        const int koffr = (i0 - w0) >> 4;
        float mx = -INFINITY, den = 0.f; f32x4 oacc[8];
        {
            const float c1 = 0.08838834764831845f * 1.4426950408889634f, sl2 = exp2f(-0.5f * (float)(h + 1)) * (float)r * 1.4426950408889634f;
            int lv = lane; asm volatile("" : "+v"(lv));
            const int e0 = (lv & 15) - 4 * (lv >> 4);
            float ae[4];
#pragma unroll
            for (int jj = 0; jj < 4; ++jj) ae[jj] = -sl2 * (float)(e0 - jj);
            f32x4 sacc[10];
            LAS unsigned char* kbase = Ks + (w0 + 16 * koffr + fr) * RS + 16 * g;
            bf16x8 kfb[2][4];
#pragma unroll
            for (int ks = 0; ks < 4; ++ks) kfb[0][ks] = *(const LAS bf16x8*)(kbase + 64 * ks);
            sacc[9] = (f32x4){0.f, 0.f, 0.f, 0.f};
#pragma unroll
            for (int i = 0; i < 9; ++i) {
                if (i + 1 < 9) {
#pragma unroll
                    for (int ks = 0; ks < 4; ++ks) kfb[(i + 1) & 1][ks] = *(const LAS bf16x8*)(kbase + 16 * (i + 1) * RS + 64 * ks); }
                f32x4 a = (f32x4){0.f, 0.f, 0.f, 0.f};
                __builtin_amdgcn_s_setprio(1);
#pragma unroll
                for (int ks = 0; ks < 4; ++ks) a = mfma16(kfb[i & 1][ks], qf[ks], a);
                __builtin_amdgcn_s_setprio(0);
                const float tc = (koffr + i < ktlo) ? -INFINITY : sl2 * (float)(16 * i - 128);
#pragma unroll
                for (int jj = 0; jj < 4; ++jj) { float sv = fmaf(a[jj], c1, ae[jj] + tc);
                    if (i == 0) sv = (e0 - jj <= 0) ? sv : -INFINITY;
                    if (i == 8) sv = (e0 - jj >= 0) ? sv : -INFINITY;
                    a[jj] = sv; mx = fmaxf(mx, sv); }
                sacc[i] = a;
                asm volatile("" ::: "memory"); }
            if (ii + 1 < nit) ATT_LOADQ(itn);
            mx = fmaxf(mx, __shfl_xor(mx, 16)); mx = fmaxf(mx, __shfl_xor(mx, 32));
#pragma unroll
            for (int i = 0; i < 9; ++i)
#pragma unroll
                for (int jj = 0; jj < 4; ++jj) { const float pe = __builtin_amdgcn_exp2f(sacc[i][jj] - mx); den += pe; sacc[i][jj] = pe; }
            den += __shfl_xor(den, 16); den += __shfl_xor(den, 32);
#pragma unroll
            for (int dt = 0; dt < 8; ++dt) oacc[dt] = (f32x4){0.f, 0.f, 0.f, 0.f};
            LAS unsigned char* vbase = Vs + (w0 + 16 * koffr + 4 * g + q4) * VRS + 8 * p4;
            bf16x8 vfb[2][2]; bf16x8 pf;
#pragma unroll
            for (int d = 0; d < 2; ++d) vfb[0][d] = tr8(vbase + 32 * d, vbase + 32 * d + 16 * VRS);
#pragma unroll
            for (int u = 0; u < 20; ++u) { const int ks2 = u >> 2, qtr = u & 3;
                if (u + 1 < 20) { const int k2n = (u + 1) >> 2, qn = (u + 1) & 3; LAS unsigned char* vb = vbase + 32 * k2n * VRS;
#pragma unroll
                    for (int d = 0; d < 2; ++d) vfb[(u + 1) & 1][d] = tr8(vb + 32 * (2 * qn + d), vb + 32 * (2 * qn + d) + (k2n == 4 ? 0 : 16 * VRS)); }
                if (qtr == 0) { u32x4 pw; pw.x = cvt_pk_bf16(sacc[2 * ks2][0], sacc[2 * ks2][1]); pw.y = cvt_pk_bf16(sacc[2 * ks2][2], sacc[2 * ks2][3]);
                    pw.z = cvt_pk_bf16(sacc[2 * ks2 + 1][0], sacc[2 * ks2 + 1][1]); pw.w = cvt_pk_bf16(sacc[2 * ks2 + 1][2], sacc[2 * ks2 + 1][3]);
                    pf = __builtin_bit_cast(bf16x8, pw); }
                __builtin_amdgcn_s_setprio(1);
#pragma unroll
                for (int d = 0; d < 2; ++d) oacc[2 * qtr + d] = mfma16(vfb[u & 1][d], pf, oacc[2 * qtr + d]);
                __builtin_amdgcn_s_setprio(0);
                asm volatile("" ::: "memory"); }
        }
        const float inv = 1.f / den;
        const size_t tqo = tok0 + (size_t)(n * 128 + i0 + fr) * r + php;
        bf16_t* op = slot(p, 4 + pat) + tqo * DM + h * 128 + 4 * g;
#pragma unroll
        for (int dt = 0; dt < 8; ++dt) { u32x2 w; w.x = cvt_pk_bf16(oacc[dt][0] * inv, oacc[dt][1] * inv); w.y = cvt_pk_bf16(oacc[dt][2] * inv, oacc[dt][3] * inv);
            *(u32x2*)(op + 16 * dt) = w; }
        if (g == 0) lse[(size_t)pat * M_TOK * 16 + tqo * 16 + h] = (mx + __log2f(den)) * 0.6931471805599453f;
    }
#undef ATT_LOADKV
#undef ATT_ITEM
#undef ATT_LOADQ
#undef ATT_DECODE
}

DI void ph_comb(const Ctx cx, const Params& p) {
    const bf16_t* O0 = slot(p, 4); const bf16_t* O1 = slot(p, 5); const bf16_t* O2 = slot(p, 6); const bf16_t* Z = slot(p, 3);
    bf16_t* AG = slot(p, 7);
    const float* lse = (const float*)(p.ws + WS_LSE);
    const size_t nth = (size_t)cx.nb * 512, total = (size_t)M_TOK * 256;
    for (size_t idx0 = (size_t)cx.bid * 512 + cx.tid; idx0 < total; idx0 += 2 * nth) {
        u32x4 a0[2], a1[2], a2[2], z[2]; float l0[2], l1[2], l2[2]; size_t o[2]; bool ok[2];
#pragma unroll
        for (int q = 0; q < 2; ++q) { const size_t idx = idx0 + q * nth; ok[q] = idx < total; const size_t ix = ok[q] ? idx : idx0;
            const size_t m = ix >> 8; const int c8 = (int)(ix & 255), h = c8 >> 4; o[q] = m * DM + c8 * 8;
            l0[q] = lse[m * 16 + h]; l1[q] = lse[(size_t)M_TOK * 16 + m * 16 + h]; l2[q] = lse[(size_t)2 * M_TOK * 16 + m * 16 + h];
            a0[q] = __builtin_nontemporal_load((const u32x4*)(O0 + o[q])); a1[q] = __builtin_nontemporal_load((const u32x4*)(O1 + o[q])); a2[q] = __builtin_nontemporal_load((const u32x4*)(O2 + o[q])); z[q] = __builtin_nontemporal_load((const u32x4*)(Z + o[q])); }
#pragma unroll
        for (int q = 0; q < 2; ++q) {
            const float mxl = fmaxf(l0[q], fmaxf(l1[q], l2[q]));
            float w0 = __expf(l0[q] - mxl), w1 = __expf(l1[q] - mxl), w2 = __expf(l2[q] - mxl);
            const float inv = 1.f / (w0 + w1 + w2); w0 *= inv; w1 *= inv; w2 *= inv;
            u32x4 res;
#pragma unroll
            for (int e2 = 0; e2 < 4; ++e2) {
                const float lo = (w0 * bf_lo(a0[q][e2]) + w1 * bf_lo(a1[q][e2]) + w2 * bf_lo(a2[q][e2])) * siluf_(bf_lo(z[q][e2]));
                const float hi = (w0 * bf_hi(a0[q][e2]) + w1 * bf_hi(a1[q][e2]) + w2 * bf_hi(a2[q][e2])) * siluf_(bf_hi(z[q][e2]));
                res[e2] = cvt_pk_bf16(lo, hi); }
            if (ok[q]) *(u32x4*)(AG + o[q]) = res; }
    }
}

DI void ph_conv(const Ctx cx, const Params& p) {
    const bf16_t* U = slot(p, 0); bf16_t* QK = slot(p, 4);
    const size_t nth = (size_t)cx.nb * 512;
    for (size_t idx = (size_t)cx.bid * 512 + cx.tid; idx < (size_t)(M_TOK / 8) * 256; idx += nth) {
        const int c8 = (int)(idx & 255); const size_t t0 = (idx >> 8) * 8; const bool first = (t0 & (SEQ - 1)) == 0;
        float w[4][8], bias[8];
#pragma unroll
        for (int j = 0; j < 4; ++j) { const f32x4 a = *(const f32x4*)(p.conv_w + j * DM + c8 * 8), b2 = *(const f32x4*)(p.conv_w + j * DM + c8 * 8 + 4);
            w[j][0] = a.x; w[j][1] = a.y; w[j][2] = a.z; w[j][3] = a.w; w[j][4] = b2.x; w[j][5] = b2.y; w[j][6] = b2.z; w[j][7] = b2.w; }
        { const f32x4 a = *(const f32x4*)(p.conv_b + c8 * 8), b2 = *(const f32x4*)(p.conv_b + c8 * 8 + 4);
          bias[0] = a.x; bias[1] = a.y; bias[2] = a.z; bias[3] = a.w; bias[4] = b2.x; bias[5] = b2.y; bias[6] = b2.z; bias[7] = b2.w; }
        float u[11][8];
#pragma unroll
        for (int t = 0; t < 11; ++t) { u32x4 raw = (u32x4){0u, 0u, 0u, 0u};
            if (t >= 3 || !first) raw = *(const u32x4*)(U + (t0 + t - 3) * DM + c8 * 8);
#pragma unroll
            for (int e = 0; e < 4; ++e) { u[t][2 * e] = bf_lo(raw[e]); u[t][2 * e + 1] = bf_hi(raw[e]); } }
        const float osc = c8 >= 128 ? 0.08838834764831845f : 1.f;
#pragma unroll
        for (int t = 0; t < 8; ++t) { float y[8];
#pragma unroll
            for (int e = 0; e < 8; ++e) { float a = bias[e];
#pragma unroll
                for (int j = 0; j < 4; ++j) a += w[j][e] * u[t + j][e];
                y[e] = siluf_(a) * osc; }
            u32x4 res; res.x = cvt_pk_bf16(y[0], y[1]); res.y = cvt_pk_bf16(y[2], y[3]); res.z = cvt_pk_bf16(y[4], y[5]); res.w = cvt_pk_bf16(y[6], y[7]);
            *(u32x4*)(QK + (t0 + t) * DM + c8 * 8) = res; }
    }
}

DI void ph_mlstm(const Ctx cx, const Params& p, LAS unsigned char* lds) {
    const bf16_t* QK = slot(p, 4); const bf16_t* Vg = slot(p, 1); bf16_t* Hb = slot(p, 5);
    const float* igp = (const float*)(p.ws + WS_GATES); const float* lfp = igp + M_TOK * 8;
    const int tid = cx.tid, wave = __builtin_amdgcn_readfirstlane(tid >> 6), lane = tid & 63, fr = lane & 15, g = lane >> 4, q4 = fr >> 2, p4 = fr & 3;
    constexpr int RS = 272, VS = 112, BUF = 56576, O_Q = 0, O_K = 17408, O_V = 34816, O_C = 41984, O_G = 55040;
    constexpr int O_TB = 2 * BUF;
    const int tt = wave >> 1, wb = wave & 1;
    const u32x4 zero4 = (u32x4){0u, 0u, 0u, 0u};
    for (int item = cx.bid; item < 256; item += cx.nb) {
        int bhi = item >> 3, dvs = item & 7;
        if (cx.nb == 256) { bhi = (item & 7) * 4 + (item >> 6); dvs = (item >> 3) & 7; }
        const int b = bhi >> 3, h = bhi & 7;
        const size_t tok0 = (size_t)b * SEQ;
        __syncthreads();
        if (tid < 256) { const int bsel = tid >> 7, row = (tid >> 1) & 63, hf = tid & 1;
            *(LAS u32x4*)(lds + bsel * BUF + O_V + row * VS + 64 + hf * 16) = hf ? zero4 : (u32x4){0x3F80u, 0u, 0u, 0u}; }
        for (int i = tid; i < 816; i += 512) *(LAS u32x4*)(lds + O_C + i * 16) = zero4;
        f32x4 C[3];
#pragma unroll
        for (int ct = 0; ct < 3; ++ct) C[ct] = (f32x4){0.f, 0.f, 0.f, 0.f};
        float m_st = 0.f;
        struct PFSet { u32x4 q[2], k[2], v; };
        PFSet s0, s1; s0.v = zero4; s1.v = zero4;
        float gi = 0.f, gl = 0.f;
        const int prow = tid >> 4, pch = tid & 15;
#define ML_PREFETCH(S, cc) do { const size_t tb = tok0 + (size_t)(cc) * 64; \
            S.q[0] = *(const u32x4*)(QK + (tb + prow) * DM + h * 128 + pch * 8); S.q[1] = *(const u32x4*)(QK + (tb + prow + 32) * DM + h * 128 + pch * 8); \
            S.k[0] = *(const u32x4*)(QK + (tb + prow) * DM + 1024 + h * 128 + pch * 8); S.k[1] = *(const u32x4*)(QK + (tb + prow + 32) * DM + 1024 + h * 128 + pch * 8); \
            if (tid < 256) S.v = *(const u32x4*)(Vg + (tb + (tid >> 2)) * DM + h * 256 + dvs * 32 + (tid & 3) * 8); \
            } while (0)
#define ML_STORE(S, bp) do { LAS unsigned char* bp_ = (bp); \
            *(LAS u32x4*)(bp_ + O_Q + prow * RS + pch * 16) = S.q[0]; *(LAS u32x4*)(bp_ + O_Q + (prow + 32) * RS + pch * 16) = S.q[1]; \
            *(LAS u32x4*)(bp_ + O_K + prow * RS + pch * 16) = S.k[0]; *(LAS u32x4*)(bp_ + O_K + (prow + 32) * RS + pch * 16) = S.k[1]; \
            if (tid < 256) *(LAS u32x4*)(bp_ + O_V + (tid >> 2) * VS + (tid & 3) * 16) = S.v; } while (0)
#define ML_GLOAD(cc) do { const size_t tb = tok0 + (size_t)(cc) * 64; gi = igp[(tb + lane) * 8 + h]; gl = lfp[(tb + lane) * 8 + h]; } while (0)
#define ML_SCAN(cc) do { LAS float* tb_ = (LAS float*)(lds + O_TB) + ((cc) & 15) * 192; float bcs = gl; \
            _Pragma("unroll") for (int o = 1; o < 64; o <<= 1) { const float t_ = __shfl_up(bcs, o); if (lane >= o) bcs += t_; } \
            const float uu = gi - bcs; float cmx = uu; \
            _Pragma("unroll") for (int o = 1; o < 64; o <<= 1) { const float t_ = __shfl_up(cmx, o); if (lane >= o) cmx = fmaxf(cmx, t_); } \
            tb_[lane] = uu; tb_[64 + lane] = cmx; tb_[128 + lane] = bcs; } while (0)
#define ML_GATES(cc, bp) do { if (wave == 0) { const LAS float* tb_ = (const LAS float*)(lds + O_TB) + ((cc) & 15) * 192; LAS float* ga_ = (LAS float*)((bp) + O_G); \
            const float uu = tb_[lane], cmx = tb_[64 + lane], bcs = tb_[128 + lane]; \
            const float cm = fmaxf(m_st, cmx), mt = bcs + cm; \
            const float b_last = __int_as_float(__builtin_amdgcn_readlane(__float_as_int(bcs), 63)), cm63 = __int_as_float(__builtin_amdgcn_readlane(__float_as_int(cm), 63)); \
            ga_[lane] = uu; ga_[64 + lane] = cm; ga_[128 + lane] = __expf(m_st - cm); ga_[192 + lane] = __expf(-mt); ga_[256 + lane] = __expf(uu - cm63); \
            if (lane == 0) ga_[320] = __expf(m_st - cm63); \
            m_st = b_last + cm63; } } while (0)
        ML_GLOAD(wave); ML_SCAN(wave); ML_GLOAD(8 + wave); ML_SCAN(8 + wave);
        __syncthreads();
        ML_PREFETCH(s0, 0); ML_PREFETCH(s1, 1);
        ML_STORE(s0, lds); ML_GATES(0, lds);
        ML_PREFETCH(s0, 2);
        __syncthreads();
        for (int c2 = 0; c2 < 64; c2 += 2) {
#pragma unroll
          for (int hc = 0; hc < 2; ++hc) {
            const int c = c2 + hc;
            LAS unsigned char* cur = lds + hc * BUF; LAS unsigned char* nxt = lds + (hc ^ 1) * BUF;
            if (hc == 0) { if (c + 1 < 64) { ML_STORE(s1, nxt); ML_GATES(c + 1, nxt); if (c + 3 < 64) ML_PREFETCH(s1, c + 3); } }
            else { if (c + 1 < 64) { ML_STORE(s0, nxt); ML_GATES(c + 1, nxt); if (c + 3 < 64) ML_PREFETCH(s0, c + 3); } }
            if ((c & 7) == 0 && c + 16 + wave < 64) ML_GLOAD(c + 16 + wave);
            if ((c & 7) == 7 && c + 9 + wave < 64) ML_SCAN(c + 9 + wave);
            LAS unsigned char* qs = cur + O_Q; LAS unsigned char* ks = cur + O_K; LAS unsigned char* vs = cur + O_V; LAS unsigned char* cbs = cur + O_C;
            const LAS float* ga = (const LAS float*)(cur + O_G);
            const int t = 16 * tt + fr;
            const float cm_t = ga[64 + t], wi_t = ga[128 + t], emt_t = ga[192 + t];
            bf16x8 qf[4];
#pragma unroll
            for (int k4 = 0; k4 < 4; ++k4) qf[k4] = *(const LAS bf16x8*)(qs + t * RS + (32 * k4 + 8 * g) * 2);
            f32x4 sT[4];
#pragma unroll
            for (int st = 0; st < 4; ++st) { sT[st] = (f32x4){0.f, 0.f, 0.f, 0.f};
                if (st <= tt) {
#pragma unroll
                    for (int k4 = 0; k4 < 4; ++k4) { const bf16x8 kf = *(const LAS bf16x8*)(ks + (16 * st + fr) * RS + (32 * k4 + 8 * g) * 2); sT[st] = mfma16(kf, qf[k4], sT[st]); }
                    const f32x4 u4 = *(const LAS f32x4*)(ga + 16 * st + 4 * g);
#pragma unroll
                    for (int jj = 0; jj < 4; ++jj) { const int s = 16 * st + 4 * g + jj; sT[st][jj] *= (s <= t) ? __expf(u4[jj] - cm_t) : 0.f; } } }
            f32x4 nA = (f32x4){0.f, 0.f, 0.f, 0.f}, nD = nA, iA = nA, iD = nA;
#pragma unroll
            for (int k2 = 0; k2 < 2; ++k2) {
                if (2 * k2 <= tt) {
                    u32x4 sw; sw.x = cvt_pk_bf16(sT[2 * k2][0], sT[2 * k2][1]); sw.y = cvt_pk_bf16(sT[2 * k2][2], sT[2 * k2][3]);
                    sw.z = cvt_pk_bf16(sT[2 * k2 + 1][0], sT[2 * k2 + 1][1]); sw.w = cvt_pk_bf16(sT[2 * k2 + 1][2], sT[2 * k2 + 1][3]);
                    const bf16x8 scf = __builtin_bit_cast(bf16x8, sw);
                    LAS unsigned char* vb = vs + (32 * k2 + 4 * g + q4) * VS + 8 * p4;
                    const bf16x8 vA = tr8(vb + 32 * wb, vb + 32 * wb + 16 * VS);
                    const bf16x8 vD = tr8(vb + 64, vb + 64 + 16 * VS);
                    nA = mfma16(vA, scf, nA); nD = mfma16(vD, scf, nD); } }
#pragma unroll
            for (int k4 = 0; k4 < 4; ++k4) {
                const bf16x8 cA = *(const LAS bf16x8*)(cbs + (16 * wb + fr) * RS + (32 * k4 + 8 * g) * 2);
                const bf16x8 cD = *(const LAS bf16x8*)(cbs + (32 + fr) * RS + (32 * k4 + 8 * g) * 2);
                iA = mfma16(cA, qf[k4], iA); iD = mfma16(cD, qf[k4], iD); }
            {
                float den = wi_t * iD[0] + nD[0];
                den = __shfl(den, fr);
                const float dinv = 1.f / fmaxf(fabsf(den), emt_t);
                u32x2 w; w.x = cvt_pk_bf16((wi_t * iA[0] + nA[0]) * dinv, (wi_t * iA[1] + nA[1]) * dinv); w.y = cvt_pk_bf16((wi_t * iA[2] + nA[2]) * dinv, (wi_t * iA[3] + nA[3]) * dinv);
                *(u32x2*)(Hb + (tok0 + (size_t)c * 64 + t) * DM + h * 256 + dvs * 32 + 16 * wb + 4 * g) = w;
            }
            {
                const float w_old = ga[320];
#pragma unroll
                for (int ct = 0; ct < 3; ++ct) C[ct] *= w_old;
#pragma unroll
                for (int k2 = 0; k2 < 2; ++k2) {
                    LAS unsigned char* kb = ks + (32 * k2 + 8 * g + q4) * RS + (16 * wave + 4 * p4) * 2;
                    const bf16x8 kraw = tr8(kb, kb + 4 * RS);
                    const f32x4 w0 = *(const LAS f32x4*)(ga + 256 + 32 * k2 + 8 * g), w1 = *(const LAS f32x4*)(ga + 256 + 32 * k2 + 8 * g + 4);
                    u32x4 ka;
                    ka.x = cvt_pk_bf16(bf1((bf16_t)kraw[0]) * w0.x, bf1((bf16_t)kraw[1]) * w0.y); ka.y = cvt_pk_bf16(bf1((bf16_t)kraw[2]) * w0.z, bf1((bf16_t)kraw[3]) * w0.w);
                    ka.z = cvt_pk_bf16(bf1((bf16_t)kraw[4]) * w1.x, bf1((bf16_t)kraw[5]) * w1.y); ka.w = cvt_pk_bf16(bf1((bf16_t)kraw[6]) * w1.z, bf1((bf16_t)kraw[7]) * w1.w);
                    const bf16x8 kf = __builtin_bit_cast(bf16x8, ka);
                    LAS unsigned char* vb = vs + (32 * k2 + 8 * g + q4) * VS + 8 * p4;
#pragma unroll
                    for (int ct = 0; ct < 3; ++ct) { const bf16x8 vf = tr8(vb + 32 * ct, vb + 32 * ct + 4 * VS); C[ct] = mfma16(kf, vf, C[ct]); }
                }
#pragma unroll
                for (int ct = 0; ct < 3; ++ct) { u32x2 w; w.x = cvt_pk_bf16(C[ct][0], C[ct][1]); w.y = cvt_pk_bf16(C[ct][2], C[ct][3]);
                    *(LAS u32x2*)(nxt + O_C + (16 * ct + fr) * RS + (16 * wave + 4 * g) * 2) = w; }
            }
            lds_barrier();
          }
        }
#undef ML_PREFETCH
#undef ML_GLOAD
#undef ML_SCAN
#undef ML_GATES
#undef ML_STORE
    }
}

DI void ph_mnorm(const Ctx cx, const Params& p) {
    bf16_t* Hb = slot(p, 5); const bf16_t* MO = slot(p, 2); const bf16_t* MZ = slot(p, 3);
    const int wave = cx.tid >> 6, lane = cx.tid & 63;
    const int gw = cx.bid * 8 + wave, NGW = cx.nb * 8;
    u32x4 hn[4], on[4], zn[4];
#define MN_LOAD(r) do { _Pragma("unroll") for (int j = 0; j < 4; ++j) { const size_t o_ = (size_t)(r) * DM + 512 * j + 8 * lane; \
        hn[j] = __builtin_nontemporal_load((const u32x4*)(Hb + o_)); on[j] = __builtin_nontemporal_load((const u32x4*)(MO + o_)); zn[j] = __builtin_nontemporal_load((const u32x4*)(MZ + o_)); } } while (0)
    if (gw < M_TOK) MN_LOAD(gw);
    for (int row = gw; row < M_TOK; row += NGW) {
        u32x4 hq[4], oq[4], zq[4];
#pragma unroll
        for (int j = 0; j < 4; ++j) { hq[j] = hn[j]; oq[j] = on[j]; zq[j] = zn[j]; }
        if (row + NGW < M_TOK) MN_LOAD(row + NGW);
#pragma unroll
        for (int j = 0; j < 4; ++j) { const size_t o = (size_t)row * DM + 512 * j + 8 * lane;
            float cv[8]; float ss = 0.f;
#pragma unroll
            for (int e2 = 0; e2 < 4; ++e2) { cv[2 * e2] = sigmoidf_(bf_lo(oq[j][e2])) * bf_lo(hq[j][e2]); cv[2 * e2 + 1] = sigmoidf_(bf_hi(oq[j][e2])) * bf_hi(hq[j][e2]);
                ss += cv[2 * e2] * cv[2 * e2] + cv[2 * e2 + 1] * cv[2 * e2 + 1]; }
#pragma unroll
            for (int of = 1; of < 32; of <<= 1) ss += __shfl_xor(ss, of);
            const float rinv = rsqrtf(ss * (1.f / 256.f) + 1e-6f);
            const f32x4 g0 = *(const f32x4*)(p.mnorm_g + 512 * j + 8 * lane), g1 = *(const f32x4*)(p.mnorm_g + 512 * j + 8 * lane + 4);
            u32x4 res;
            res.x = cvt_pk_bf16(cv[0] * rinv * g0.x * siluf_(bf_lo(zq[j].x)), cv[1] * rinv * g0.y * siluf_(bf_hi(zq[j].x)));
            res.y = cvt_pk_bf16(cv[2] * rinv * g0.z * siluf_(bf_lo(zq[j].y)), cv[3] * rinv * g0.w * siluf_(bf_hi(zq[j].y)));
            res.z = cvt_pk_bf16(cv[4] * rinv * g1.x * siluf_(bf_lo(zq[j].z)), cv[5] * rinv * g1.y * siluf_(bf_hi(zq[j].z)));
            res.w = cvt_pk_bf16(cv[6] * rinv * g1.z * siluf_(bf_lo(zq[j].w)), cv[7] * rinv * g1.w * siluf_(bf_hi(zq[j].w)));
            *(u32x4*)(Hb + o) = res; }
    }
#undef MN_LOAD
}

DI void ph_fin(const Ctx cx, const Params& p) {
    const int wave = cx.tid >> 6, lane = cx.tid & 63;
    const int gw = cx.bid * 8 + wave, NGW = cx.nb * 8;
    const bf16_t* DL = slot(p, 3);
    f32x4 xn[8]; u32x2 dn[8];
#define FN_LOAD(r) do { const f32x4* xr_ = (const f32x4*)(p.x + (size_t)(r) * DM) + lane; const u32x2* dr_ = (const u32x2*)(DL + (size_t)(r) * DM) + lane; \
        _Pragma("unroll") for (int j = 0; j < 8; ++j) { xn[j] = __builtin_nontemporal_load(xr_ + 64 * j); dn[j] = __builtin_nontemporal_load(dr_ + 64 * j); } } while (0)
    if (gw < M_TOK) FN_LOAD(gw);
    for (int row = gw; row < M_TOK; row += NGW) {
        f32x4* orow = (f32x4*)(p.out + (size_t)row * DM) + lane;
        f32x4 v[8]; float s = 0.f;
#pragma unroll
        for (int j = 0; j < 8; ++j) { v[j] = xn[j]; v[j].x += bf_lo(dn[j].x); v[j].y += bf_hi(dn[j].x); v[j].z += bf_lo(dn[j].y); v[j].w += bf_hi(dn[j].y); }
        if (row + NGW < M_TOK) FN_LOAD(row + NGW);
#pragma unroll
        for (int j = 0; j < 8; ++j) s += (v[j].x * v[j].x + v[j].y * v[j].y) + (v[j].z * v[j].z + v[j].w * v[j].w);
        s = wave_sum(s);
        const float rstd = rsqrtf(s * (1.f / DM) + 1e-6f);
#pragma unroll
        for (int j = 0; j < 8; ++j) { const f32x4 g4 = ((const f32x4*)p.final_g)[64 * j + lane]; orow[64 * j] = (v[j] * rstd) * g4; }
    }
#undef FN_LOAD
}

__global__ void __launch_bounds__(512, 2) hybrid_block_fwd(Params p) {
    extern __shared__ __attribute__((aligned(16))) unsigned char shm[];
    LAS unsigned char* lds = (LAS unsigned char*)shm;
    cg::grid_group grid = cg::this_grid();
    if (threadIdx.x < 4) ((volatile LAS unsigned*)(lds + 143360))[threadIdx.x] = 0u;
    __syncthreads();
    if (blockIdx.x == 0) { unsigned* bw = (unsigned*)(p.ws + WS_BAR); for (int i = threadIdx.x; i < XCD_BAR_WORDS; i += 512) bw[i] = 0u; }
    XcdBarrier xb; xb.bar = (unsigned*)(p.ws + WS_BAR); xb.x = 0u; xb.st = (volatile LAS unsigned*)(lds + 143360);
    for (int ph = p.ph_lo; ph < p.ph_hi; ++ph) {
        if (ph == 8 || ph == 10) continue;
        if (ph > p.ph_lo) { if (ph == p.ph_lo + 1) { grid.sync(); xb = xcd_barrier_post((unsigned*)(p.ws + WS_BAR), (volatile LAS unsigned*)(lds + 143360)); } else xcd_barrier(xb); }
#ifdef EXTRA_SYNCS
        if (ph == 3) { for (int i = 0; i < EXTRA_SYNCS; ++i) grid.sync(); }
#endif
#ifndef ONLY_PHASE
#define ONLY_PHASE -1
#endif
#ifndef REPEAT_PHASE
#define REPEAT_PHASE -1
#endif
        for (int rep = 0; rep < (ph == REPEAT_PHASE ? 2 : 1); ++rep) {
        if (rep) { if (ph == p.ph_lo) grid.sync(); else xcd_barrier(xb); }
        Ctx cx; cx.tid = threadIdx.x; cx.bid = blockIdx.x; cx.nb = gridDim.x;
        asm volatile("" : "+v"(cx.tid)); asm volatile("" : "+s"(cx.bid)); asm volatile("" : "+s"(cx.nb));
#define PHEN(k) (ONLY_PHASE < 0 || ONLY_PHASE == (k))
        switch (ph) {
        case 0: if (PHEN(0)) ph_prep(cx, p, lds); break;
        case 1: case 4: if (PHEN(1)) {
            const int grp = ph == 1 ? 0 : 1;
            EpiSplitBf16T<true> E; E.O = slot(p, 0); E.seg_stride = SLOT / 2; E.O4 = slot(p, 6); E.O5 = (bf16_t*)p.out + (size_t)32 * 1024 * 1024;
            run_gemm(cx, lds, (const bf16_t*)p.out, (const bf16_t*)(p.ws + WS_WINT) + (size_t)grp * 8192 * DM, grp == 1 ? 12288 : 8192, DM, E);
        } break;
        case 2: if (PHEN(2)) ph_attn(cx, p, lds); break;
        case 3: if (PHEN(3)) ph_comb(cx, p); break;
        case 5: if (PHEN(5)) ph_conv(cx, p); break;
        case 6: if (PHEN(6)) ph_mlstm(cx, p, lds); break;
        case 7: if (PHEN(7)) ph_mnorm(cx, p); break;
        case 9: if (PHEN(9)) { EpiMerge2 E; E.ga = slot(p, 6); E.gm = (const bf16_t*)p.out + (size_t)32 * 1024 * 1024; E.O = slot(p, 2);
            run_gemm(cx, lds, slot(p, 7), (const bf16_t*)(p.ws + WS_WA), DM, DM, E, slot(p, 5), (const bf16_t*)(p.ws + WS_WM)); } break;
        case 11: if (PHEN(11)) { EpiSplitBf16T<false> E; E.O = slot(p, 3); E.seg_stride = 0; E.O4 = nullptr; E.O5 = nullptr;
            run_gemm(cx, lds, slot(p, 2), (const bf16_t*)(p.ws + WS_WO), DM, DM, E); } break;
        case 12: if (PHEN(12)) ph_fin(cx, p); break;
        default: break;
        }
        }
    }
}

extern "C" void kernel_launch(void* const* d_in, const int* in_sizes, int n_in, void* d_out, int out_size, void* d_ws, size_t ws_size, hipStream_t stream) {
    static int grid = 0;
    if (grid == 0) {
        int dev = 0, cus = 0, per_cu = 0;
        (void)hipGetDevice(&dev);
        (void)hipDeviceGetAttribute(&cus, hipDeviceAttributeMultiprocessorCount, dev);
        (void)hipFuncSetAttribute((const void*)hybrid_block_fwd, hipFuncAttributeMaxDynamicSharedMemorySize, LDS_BYTES);
        if (hipOccupancyMaxActiveBlocksPerMultiprocessor(&per_cu, (const void*)hybrid_block_fwd, 512, LDS_BYTES) != hipSuccess || per_cu < 1) { (void)hipGetLastError(); per_cu = 1; }
        if (per_cu > 1) per_cu = 1;
        grid = cus * per_cu;
        if (ws_size < WS_SLOT + 8 * SLOT) fprintf(stderr, "kernel_launch: workspace too small: %zu\n", ws_size);
    }
    Params p{};
    p.x = (const float*)d_in[0]; p.norm_g = (const float*)d_in[1]; p.w_in = (const float*)d_in[2]; p.b_if = (const float*)d_in[3];
    p.conv_w = (const float*)d_in[4]; p.conv_b = (const float*)d_in[5]; p.mnorm_g = (const float*)d_in[6]; p.w_attn = (const float*)d_in[7];
    p.w_mlstm = (const float*)d_in[8]; p.w_out = (const float*)d_in[9]; p.final_g = (const float*)d_in[10];
    p.out = (float*)d_out; p.ws = (unsigned char*)d_ws; p.ph_lo = 0; p.ph_hi = NPHASE;
    void* args[] = {&p};
    hipError_t e = hipLaunchCooperativeKernel((const void*)hybrid_block_fwd, dim3(grid), dim3(512), args, LDS_BYTES, stream);
    if (e != hipSuccess) fprintf(stderr, "cooperative launch failed: %s (grid %d)\n", hipGetErrorString(e), grid);
}
```

```cpp
#include <hip/hip_runtime.h>
#include <hip/hip_cooperative_groups.h>
#include <cstdio>
#include <type_traits>
namespace cg = cooperative_groups;
namespace pg8 {
#define PG8_LAS __attribute__((address_space(3)))
typedef unsigned short bf16_t;
typedef short bf16x8 __attribute__((ext_vector_type(8)));
typedef float f32x4 __attribute__((ext_vector_type(4)));
typedef unsigned u32x4 __attribute__((ext_vector_type(4)));
constexpr int BM = 256, BK = 64, HALF = 128, HTB = HALF * BK * 2  , STAGE_BYTES = 8 * HTB, NXCD = 8, WGM = 8;

__host__ __device__ __forceinline__ int lds_byte(int r, int c) { const int st = (r >> 4) * 2 + (c >> 5), rr = r & 15, cc = c & 31, ob = rr * 64 + cc * 2; return st * 1024 + (ob ^ (((ob >> 9) & 1) << 5)); }
__host__ __device__ __forceinline__ void stage_rc(int b, int& R, int& C) { const int st = b / 1024, sb = b % 1024, swz = sb ^ (((sb >> 9) & 1) << 5); R = (st >> 1) * 16 + swz / 64; C = (st & 1) * 32 + (swz % 64) / 2; }
__host__ __device__ __forceinline__ int perm32(int rho) { const int n = rho >> 4, i = rho & 15; return 8 * (i >> 2) + 4 * n + (i & 3); }

struct Unit { int pm, pn; };
struct Gemm { const bf16_t* A; const bf16_t* Bt; int M, N, K; const bf16_t* A2; const bf16_t* Bt2; };

struct StaticOrder {
    int nM, nN, nwg, G, c;
    __host__ __device__ void init(int M, int N, int G_, int c_) { nM = M / BM; nN = N / BM; nwg = nM * nN; G = G_; c = c_; }
    __host__ __device__ bool next(int i, Unit& u) const {
        const long L = (long)i * G + c; if (L >= nwg) return false;
        int wgid = (int)L; { const int q = nwg / NXCD, r = nwg % NXCD, xcd = wgid % NXCD, off = wgid / NXCD; wgid = (xcd < r ? xcd * (q + 1) : r * (q + 1) + (xcd - r) * q) + off; }
        const int nig = WGM * nN, gid = wgid / nig, fm = gid * WGM, gsz = (nM - fm) < WGM ? (nM - fm) : WGM;
        u.pm = fm + ((wgid % nig) % gsz); u.pn = (wgid % nig) / gsz; return true;
    }
    __device__ __forceinline__ void a_ready(const Unit&) const {}
    __device__ __forceinline__ void done(const Unit&) const {}
};
typedef __bf16 bf16x2v_t __attribute__((ext_vector_type(2)));
typedef float f32x2v_t __attribute__((ext_vector_type(2)));
__device__ __forceinline__ unsigned cvt_pk_bf16(float lo, float hi) { const f32x2v_t f = {lo, hi}; const bf16x2v_t b = __builtin_convertvector(f, bf16x2v_t); return __builtin_bit_cast(unsigned, b); }
typedef float f32x2 __attribute__((ext_vector_type(2)));
template <class Epi, class Sched, bool STAMP = false>
__device__ __forceinline__ void gemm_phase(PG8_LAS unsigned char* lds, const Gemm g, const Sched& S, const Epi& E, unsigned long long* stamps, const int tid_in) {
    const int tid = tid_in, wid = __builtin_amdgcn_readfirstlane(tid >> 6), lane = tid & 63, wr = wid >> 2, wc = wid & 3, fr = lane & 15, fq = lane >> 4;
    const int K = g.K, nth = K / BK, nt = g.A2 ? 2 * nth : nth;
    int ts_lo = 0, ts_hi = 0, nts = 0; const unsigned long long rt_entry = STAMP ? (unsigned long long)wall_clock64() : 0ull;
#define PG8_STAMP() do { if (STAMP && wid == 0 && nts < 64) { const unsigned long long _c = (unsigned long long)clock64(); \
        ts_lo = (lane == nts) ? (int)(unsigned)_c : ts_lo; ts_hi = (lane == nts) ? (int)(unsigned)(_c >> 32) : ts_hi; ++nts; } } while (0)
    PG8_STAMP();
    unsigned voffA[2], voffB[2];
#pragma unroll
    for (int i = 0; i < 2; ++i) { int R, C; stage_rc(tid * 16 + i * 8192, R, C); const int Rb = Epi::PERM ? ((R & ~31) + perm32(R & 31)) : R;
        voffA[i] = (unsigned)(R * K + C) * 2u; voffB[i] = (unsigned)(Rb * K + C) * 2u; }
    const size_t kstep = (size_t)(BK * 2);
    const size_t hstep = (size_t)HALF * K * 2;
    const size_t tstep = 2 * hstep;
    const unsigned ldsw = (unsigned)wid * 1024u;
    const int aoff = lds_byte(wr * 64 + fr, fq * 8), boff = lds_byte(wc * 32 + fr, fq * 8);
#define PG8_SA(b, h) (((b) * 2 + (h)) * HTB)
#define PG8_SB(b, h) ((4 + (b) * 2 + (h)) * HTB)
#define PG8_STAGE(bufoff, gbase, voff) do { _Pragma("unroll") for (int _i = 0; _i < 2; ++_i) \
        __builtin_amdgcn_global_load_lds((const unsigned*)((const char*)(gbase) + (voff)[_i]), (PG8_LAS unsigned*)(lds + (bufoff) + ldsw + _i * 8192), 16, 0, 0); } while (0)
#define PG8_LDA(dst, b, h) do { _Pragma("unroll") for (int m = 0; m < 4; ++m) _Pragma("unroll") for (int k = 0; k < 2; ++k) dst[m][k] = *(const PG8_LAS bf16x8*)(lds + PG8_SA(b, h) + aoff + m * 2048 + k * 1024); } while (0)
#define PG8_LDB(dst, b, h) do { _Pragma("unroll") for (int n = 0; n < 2; ++n) _Pragma("unroll") for (int k = 0; k < 2; ++k) dst[n][k] = *(const PG8_LAS bf16x8*)(lds + PG8_SB(b, h) + boff + n * 2048 + k * 1024); } while (0)
#define PG8_MMA(ai, bj, At, Bt) do { __builtin_amdgcn_s_setprio(1); _Pragma("unroll") for (int m = 0; m < 4; ++m) _Pragma("unroll") for (int n = 0; n < 2; ++n) _Pragma("unroll") for (int k = 0; k < 2; ++k) \
        acc[ai][bj][m][n] = __builtin_amdgcn_mfma_f32_16x16x32_bf16(Bt[n][k], At[m][k], acc[ai][bj][m][n], 0, 0, 0); __builtin_amdgcn_s_setprio(0); } while (0)
#define PG8_WAIT_V(n) asm volatile("s_waitcnt vmcnt(" #n ")" ::: "memory")
#define PG8_WAIT_L(n) asm volatile("s_waitcnt lgkmcnt(" #n ")" ::: "memory")
#define PG8_BAR __builtin_amdgcn_s_barrier()
#define PG8_SCHED __builtin_amdgcn_sched_barrier(0)
    Unit cur, nxt; int ui = 0;
    if (!S.next(0, cur)) return;
    f32x4 acc[2][2][4][2];
#pragma unroll
    for (int a = 0; a < 2; ++a)
#pragma unroll
        for (int b = 0; b < 2; ++b)
#pragma unroll
            for (int m = 0; m < 4; ++m)
#pragma unroll
                for (int n = 0; n < 2; ++n) acc[a][b][m][n] = (f32x4){0.f, 0.f, 0.f, 0.f};
    bf16x8 At[4][2], B0[2][2], B1[2][2];
    const char* cA = (const char*)g.A + (size_t)cur.pm * tstep; const char* cB = (const char*)g.Bt + (size_t)cur.pn * tstep;
    const char* cA2 = g.A2 ? (const char*)g.A2 + (size_t)cur.pm * tstep : cA; const char* cB2 = g.Bt2 ? (const char*)g.Bt2 + (size_t)cur.pn * tstep : cB;
#define PG8_KT(u1, u2, tix) ((tix) < nth ? (u1) + (size_t)(tix) * kstep : (u2) + (size_t)((tix) - nth) * kstep)
    S.a_ready(cur);
    PG8_STAGE(PG8_SB(0, 0), cB, voffB); PG8_STAGE(PG8_SA(0, 0), cA, voffA); PG8_STAGE(PG8_SB(0, 1), cB + hstep, voffB); PG8_STAGE(PG8_SA(0, 1), cA + hstep, voffA);
    if (wr == 1) PG8_BAR;
    PG8_WAIT_V(4); PG8_BAR;
    PG8_STAGE(PG8_SB(1, 0), cB + kstep, voffB); PG8_STAGE(PG8_SA(1, 0), cA + kstep, voffA); PG8_STAGE(PG8_SB(1, 1), cB + hstep + kstep, voffB);
    PG8_WAIT_V(6); PG8_BAR;
    PG8_STAMP();
    for (;;) {
        const bool has_next = S.next(ui + 1, nxt);
        const char* nA = has_next ? (const char*)g.A + (size_t)nxt.pm * tstep : cA; const char* nB = has_next ? (const char*)g.Bt + (size_t)nxt.pn * tstep : cB;
        for (int t = 0; t < nt; t += 2) {
            const bool last = (t == nt - 2);
            if constexpr (Epi::HAS_MID) { if (t == nth) { PG8_SCHED; E.mid(acc, cur, wr, wc, fr, fq); PG8_SCHED; } }
            const char* a1 = PG8_KT(cA, cA2, t + 1);
            const char* a2 = last ? nA : PG8_KT(cA, cA2, t + 2); const char* b2 = last ? nB : PG8_KT(cB, cB2, t + 2);
            const char* a3 = last ? nA + kstep : PG8_KT(cA, cA2, t + 3); const char* b3 = last ? nB + kstep : PG8_KT(cB, cB2, t + 3);
            if (last && has_next) S.a_ready(nxt);
            PG8_LDB(B0, 0, 0); PG8_SCHED; PG8_LDA(At, 0, 0); PG8_STAGE(PG8_SA(1, 1), a1 + hstep, voffA);
            PG8_WAIT_L(8); PG8_BAR; PG8_WAIT_L(0); PG8_MMA(0, 0, At, B0); PG8_BAR; PG8_SCHED;
            PG8_LDB(B1, 0, 1); PG8_STAGE(PG8_SB(0, 0), b2, voffB);
            PG8_BAR; PG8_WAIT_L(0); PG8_MMA(0, 1, At, B1); PG8_BAR;
            PG8_LDA(At, 0, 1); PG8_STAGE(PG8_SA(0, 0), a2, voffA);
            PG8_BAR; PG8_WAIT_L(0); PG8_MMA(1, 0, At, B0); PG8_BAR; PG8_SCHED;
            PG8_STAGE(PG8_SB(0, 1), b2 + hstep, voffB);
            PG8_WAIT_V(6); PG8_BAR; PG8_MMA(1, 1, At, B1); PG8_BAR;
            PG8_LDB(B0, 1, 0); PG8_SCHED; PG8_LDA(At, 1, 0); PG8_STAGE(PG8_SA(0, 1), a2 + hstep, voffA);
            PG8_WAIT_L(8); PG8_BAR; PG8_WAIT_L(0); PG8_MMA(0, 0, At, B0); PG8_BAR; PG8_SCHED;
            PG8_LDB(B1, 1, 1); PG8_STAGE(PG8_SB(1, 0), b3, voffB);
            PG8_BAR; PG8_WAIT_L(0); PG8_MMA(0, 1, At, B1); PG8_BAR;
            PG8_LDA(At, 1, 1); PG8_STAGE(PG8_SA(1, 0), a3, voffA);
            PG8_BAR; PG8_WAIT_L(0); PG8_MMA(1, 0, At, B0); PG8_BAR; PG8_SCHED;
            PG8_STAGE(PG8_SB(1, 1), b3 + hstep, voffB);
            PG8_WAIT_V(6); PG8_BAR; PG8_MMA(1, 1, At, B1); PG8_BAR;
        }
        PG8_STAMP();
        if constexpr (!Epi::AFTER_DRAIN) { E(acc, cur, wr, wc, fr, fq); S.done(cur); }
        PG8_STAMP();
        if (!has_next) break;
#pragma unroll
        for (int a = 0; a < 2; ++a)
#pragma unroll
            for (int b = 0; b < 2; ++b)
#pragma unroll
                for (int m = 0; m < 4; ++m)
#pragma unroll
                    for (int n = 0; n < 2; ++n) acc[a][b][m][n] = (f32x4){0.f, 0.f, 0.f, 0.f};
        cur = nxt; cA = nA; cB = nB; ++ui;
        cA2 = g.A2 ? (const char*)g.A2 + (size_t)cur.pm * tstep : cA; cB2 = g.Bt2 ? (const char*)g.Bt2 + (size_t)cur.pn * tstep : cB;
    }
    PG8_WAIT_V(0);
    if (wr == 0) PG8_BAR;
    PG8_BAR;
    if constexpr (Epi::AFTER_DRAIN) { E.fused(acc, cur, wr, wc, fr, fq, lds, wid, lane); S.done(cur); }
    PG8_STAMP();
    if (STAMP && wid == 0) { stamps[lane] = lane < nts ? (((unsigned long long)(unsigned)ts_hi << 32) | (unsigned)ts_lo) : 0ull;
        if (lane == 62) stamps[62] = rt_entry; if (lane == 63) stamps[63] = (unsigned long long)wall_clock64(); }
#undef PG8_STAMP
#undef PG8_SA
#undef PG8_SB
#undef PG8_STAGE
#undef PG8_LDA
#undef PG8_LDB
#undef PG8_MMA
#undef PG8_WAIT_V
#undef PG8_WAIT_L
#undef PG8_BAR
#undef PG8_SCHED
#undef PG8_KT
}
}


using pg8::bf16_t; using pg8::bf16x8; using pg8::f32x4; using pg8::u32x4; using pg8::cvt_pk_bf16;
typedef short s16x4 __attribute__((ext_vector_type(4)));
typedef unsigned u32x2 __attribute__((ext_vector_type(2)));
#define LAS __attribute__((address_space(3)))
#define DI __device__ __forceinline__
#define XB_TMO      128
#define XB_XCNT(j)  (256  + 64 * (j))
#define XB_XSUB(j)  (1280 + 64 * (j))
#define XB_XGEN(j)  (2304 + 64 * (j))
#define XB_TOP      3328
#define XB_TOPGEN   3392
#define XCD_BAR_WORDS 3456
#define XB_SPIN_CAP (1u << 22)

__device__ __forceinline__ unsigned xb_ld(unsigned* p)              { return __hip_atomic_load(p, __ATOMIC_RELAXED, __HIP_MEMORY_SCOPE_AGENT); }
__device__ __forceinline__ unsigned xb_add(unsigned* p, unsigned v) { return __hip_atomic_fetch_add(p, v, __ATOMIC_RELAXED, __HIP_MEMORY_SCOPE_AGENT); }
__device__ __forceinline__ unsigned xb_xcc_id() { return (unsigned)__builtin_amdgcn_s_getreg((3 << 11) | 20) & 0xFu; }
#define XB_SPIN(cond, bar) do { unsigned _sp = 0; while (cond) { __builtin_amdgcn_s_sleep(1); \
    if ((++_sp & 255u) == 0u) { if (xb_ld(&(bar)[XB_TMO])) break; if (_sp > XB_SPIN_CAP) { atomicAdd(&(bar)[XB_TMO], 1u); break; } } } } while (0)

struct XcdBarrier {
    unsigned* bar; unsigned x;
    volatile LAS unsigned* st;
};

__device__ __forceinline__ XcdBarrier xcd_barrier_post(unsigned* bar, volatile LAS unsigned* st) {
    XcdBarrier b; b.bar = bar; b.x = xb_xcc_id(); b.st = st;
    if (threadIdx.x == 0) (void)xb_add(&bar[XB_XCNT(b.x)], 1u);
    return b;
}
__device__ __forceinline__ void xcd_barrier_complete(unsigned* bar, unsigned x, unsigned& nloc, unsigned& nx) {
    const unsigned G = gridDim.x * gridDim.y * gridDim.z;
    unsigned sum, cnt, mine, sp = 0u;
    for (;;) {
        sum = 0u; cnt = 0u; mine = 0u;
#pragma unroll
        for (unsigned j = 0; j < 16; ++j) { const unsigned c = xb_ld(&bar[XB_XCNT(j)]); sum += c; cnt += (c > 0u) ? 1u : 0u; mine = (j == x) ? c : mine; }
        if (sum == G) break;
        __builtin_amdgcn_s_sleep(1);
        if ((++sp & 255u) == 0u) { if (xb_ld(&bar[XB_TMO])) break; if (sp > XB_SPIN_CAP) { atomicAdd(&bar[XB_TMO], 1u); break; } }
    }
    nloc = mine > 0u ? mine : 1u; nx = cnt > 0u ? cnt : 1u;
}

__device__ __forceinline__ void xcd_barrier(const XcdBarrier& b) {
    asm volatile("s_waitcnt vmcnt(0)" ::: "memory");
    __syncthreads();
    if (threadIdx.x == 0) {
        unsigned* bar = b.bar;
        __builtin_amdgcn_s_waitcnt(0);
        unsigned nloc = b.st[0], nx = b.st[1];
        if (nloc == 0u) { xcd_barrier_complete(bar, b.x, nloc, nx); b.st[0] = nloc; b.st[1] = nx; }
        const unsigned old = xb_add(&bar[XB_XSUB(b.x)], 1u);
        const unsigned gen = old / nloc;
        if (old + 1u == (gen + 1u) * nloc) {
            __builtin_amdgcn_fence(__ATOMIC_RELEASE, "agent");
            asm volatile("s_waitcnt vmcnt(0)" ::: "memory");
            const unsigned og = xb_add(&bar[XB_TOP], 1u);
            const unsigned tg = og / nx;
            if (og + 1u == (tg + 1u) * nx) xb_add(&bar[XB_TOPGEN], 1u);
            else XB_SPIN(xb_ld(&bar[XB_TOPGEN]) == tg, bar);
            __builtin_amdgcn_fence(__ATOMIC_ACQUIRE, "agent");
            xb_add(&bar[XB_XGEN(b.x)], 1u);
            asm volatile("s_waitcnt vmcnt(0)" ::: "memory");
        } else {
            XB_SPIN(xb_ld(&bar[XB_XGEN(b.x)]) == gen, bar);
            __builtin_amdgcn_fence(__ATOMIC_ACQUIRE, "agent");
            asm volatile("s_waitcnt vmcnt(0)" ::: "memory");
        }
    }
    __syncthreads();
}


constexpr int M_TOK = 16384, DM = 2048, SEQ = 4096, INW = 20496;
constexpr size_t MiB = (size_t)1 << 20;
constexpr size_t WS_WINT = 0, WS_WA = 80 * MiB, WS_WM = 88 * MiB, WS_WO = 96 * MiB, WS_GATES = 104 * MiB, WS_LSE = 105 * MiB, WS_BAR = 108 * MiB, WS_SLOT = 112 * MiB, SLOT = 64 * MiB;
constexpr int LDS_BYTES = 143360 + 16;
constexpr int NPHASE = 13;

struct Params {
    const float *x, *norm_g, *w_in, *b_if, *conv_w, *conv_b, *mnorm_g, *w_attn, *w_mlstm, *w_out, *final_g;
    float* out; unsigned char* ws; int ph_lo, ph_hi;
};

struct Ctx { int tid, bid, nb; };
DI void lds_barrier() { asm volatile("s_waitcnt lgkmcnt(0)" ::: "memory"); __builtin_amdgcn_s_barrier(); asm volatile("" ::: "memory"); }
DI float bf_lo(unsigned u) { return __uint_as_float(u << 16); }
DI float bf_hi(unsigned u) { return __uint_as_float(u & 0xffff0000u); }
DI float bf1(bf16_t b) { return __uint_as_float(((unsigned)b) << 16); }
DI bf16_t f2bf(float f) { return (bf16_t)(cvt_pk_bf16(f, 0.f) & 0xffffu); }
DI float sigmoidf_(float z) { return __builtin_amdgcn_rcpf(1.f + __expf(-z)); }
DI float siluf_(float z) { return z * sigmoidf_(z); }
DI float wave_sum(float v) {
#pragma unroll
    for (int o = 1; o < 64; o <<= 1) v += __shfl_xor(v, o);
    return v;
}
DI bf16_t* slot(const Params& p, int i) { return (bf16_t*)(p.ws + WS_SLOT + (size_t)i * SLOT); }
DI f32x4 mfma16(bf16x8 a, bf16x8 b, f32x4 c) { return __builtin_amdgcn_mfma_f32_16x16x32_bf16(a, b, c, 0, 0, 0); }
DI bf16x8 tr8(LAS unsigned char* lo, LAS unsigned char* hi) {
    s16x4 a = __builtin_amdgcn_ds_read_tr16_b64_v4i16((LAS s16x4*)lo);
    s16x4 b = __builtin_amdgcn_ds_read_tr16_b64_v4i16((LAS s16x4*)hi);
    return __builtin_shufflevector(a, b, 0, 1, 2, 3, 4, 5, 6, 7);
}

template <bool NT> struct EpiSplitBf16T {
    static constexpr bool PERM = true, AFTER_DRAIN = false, HAS_MID = false;
    bf16_t* O; size_t seg_stride; bf16_t* O4; bf16_t* O5;
    DI void operator()(const f32x4 (&acc)[2][2][4][2], const pg8::Unit& u, int wr, int wc, int fr, int fq) const {
        const int row0 = u.pm * 256 + wr * 64 + fr; int colt = u.pn * 256; const int seg = colt >> 11; colt &= 2047;
        bf16_t* base = seg < 4 ? O + (size_t)seg * seg_stride : (seg == 4 ? O4 : O5); const int col0 = colt + wc * 32 + 8 * fq;
#pragma unroll
        for (int ai = 0; ai < 2; ++ai)
#pragma unroll
            for (int m = 0; m < 4; ++m) { bf16_t* rowp = base + (size_t)(row0 + ai * 128 + m * 16) * DM + col0;
#pragma unroll
                for (int bj = 0; bj < 2; ++bj) { const f32x4 v0 = acc[ai][bj][m][0], v1 = acc[ai][bj][m][1];
                    u32x4 w; w.x = cvt_pk_bf16(v0[0], v0[1]); w.y = cvt_pk_bf16(v0[2], v0[3]); w.z = cvt_pk_bf16(v1[0], v1[1]); w.w = cvt_pk_bf16(v1[2], v1[3]);
                    if (NT) __builtin_nontemporal_store(w, (u32x4*)(rowp + bj * 128)); else *(u32x4*)(rowp + bj * 128) = w; } }
    }
};
template <int MODE> struct EpiGate {
    static constexpr bool PERM = true, AFTER_DRAIN = false, HAS_MID = false;
    const bf16_t* gate; float* T; bf16_t* O;
    DI void operator()(const f32x4 (&acc)[2][2][4][2], const pg8::Unit& u, int wr, int wc, int fr, int fq) const {
        const int row0 = u.pm * 256 + wr * 64 + fr, col0 = u.pn * 256 + wc * 32 + 8 * fq;
#pragma unroll
        for (int ai = 0; ai < 2; ++ai)
#pragma unroll
            for (int m = 0; m < 4; ++m) { const size_t ro = (size_t)(row0 + ai * 128 + m * 16) * DM + col0;
#pragma unroll
                for (int bj = 0; bj < 2; ++bj) { const size_t o = ro + bj * 128;
                    const u32x4 gq = *(const u32x4*)(gate + o);
                    f32x4 v0 = acc[ai][bj][m][0], v1 = acc[ai][bj][m][1];
                    v0[0] *= sigmoidf_(bf_lo(gq.x)); v0[1] *= sigmoidf_(bf_hi(gq.x)); v0[2] *= sigmoidf_(bf_lo(gq.y)); v0[3] *= sigmoidf_(bf_hi(gq.y));
                    v1[0] *= sigmoidf_(bf_lo(gq.z)); v1[1] *= sigmoidf_(bf_hi(gq.z)); v1[2] *= sigmoidf_(bf_lo(gq.w)); v1[3] *= sigmoidf_(bf_hi(gq.w));
                    if (MODE == 0) { *(f32x4*)(T + o) = v0; *(f32x4*)(T + o + 4) = v1; }
                    else { v0 += *(const f32x4*)(T + o); v1 += *(const f32x4*)(T + o + 4);
                        u32x4 w; w.x = cvt_pk_bf16(v0[0], v0[1]); w.y = cvt_pk_bf16(v0[2], v0[3]); w.z = cvt_pk_bf16(v1[0], v1[1]); w.w = cvt_pk_bf16(v1[2], v1[3]);
                        *(u32x4*)(O + o) = w; } } }
    }
};
struct EpiResid {
    static constexpr bool PERM = false, AFTER_DRAIN = false, HAS_MID = false;
    const float* x; float* out;
    DI void operator()(const f32x4 (&acc)[2][2][4][2], const pg8::Unit& u, int wr, int wc, int fr, int fq) const {
        const int row0 = u.pm * 256 + wr * 64 + fr, col0 = u.pn * 256 + wc * 32 + 4 * fq;
#pragma unroll
        for (int ai = 0; ai < 2; ++ai)
#pragma unroll
            for (int m = 0; m < 4; ++m) { const size_t ro = (size_t)(row0 + ai * 128 + m * 16) * DM + col0;
#pragma unroll
                for (int bj = 0; bj < 2; ++bj)
#pragma unroll
                    for (int n = 0; n < 2; ++n) { const size_t o = ro + bj * 128 + n * 16; *(f32x4*)(out + o) = acc[ai][bj][m][n] + *(const f32x4*)(x + o); } }
    }
};
struct EpiMerge2 {
    static constexpr bool PERM = true, AFTER_DRAIN = false, HAS_MID = true;
    const bf16_t* ga; const bf16_t* gm; bf16_t* O;
    DI void mid(f32x4 (&acc)[2][2][4][2], const pg8::Unit& u, int wr, int wc, int fr_, int fq) const {
        int fr = fr_; asm volatile("" : "+v"(fr));
        const int row0 = u.pm * 256 + wr * 64 + fr, col0 = u.pn * 256 + wc * 32 + 8 * fq;
#pragma unroll
        for (int ai = 0; ai < 2; ++ai)
#pragma unroll
            for (int m = 0; m < 4; ++m) { const size_t ro = (size_t)(row0 + ai * 128 + m * 16) * DM + col0;
#pragma unroll
                for (int bj = 0; bj < 2; ++bj) { const size_t o = ro + bj * 128;
                    const u32x4 aq = *(const u32x4*)(ga + o), mq = *(const u32x4*)(gm + o);
#pragma unroll
                    for (int e = 0; e < 4; ++e) {
                        const float rl = (1.f + __expf(-bf_lo(mq[e]))) * __builtin_amdgcn_rcpf(1.f + __expf(-bf_lo(aq[e])));
                        const float rh = (1.f + __expf(-bf_hi(mq[e]))) * __builtin_amdgcn_rcpf(1.f + __expf(-bf_hi(aq[e])));
                        acc[ai][bj][m][e >> 1][(2 * e) & 3] *= rl; acc[ai][bj][m][e >> 1][((2 * e) & 3) + 1] *= rh; } }
                asm volatile("" ::: "memory"); }
    }
    DI void operator()(const f32x4 (&acc)[2][2][4][2], const pg8::Unit& u, int wr, int wc, int fr_, int fq) const {
        int fr = fr_; asm volatile("" : "+v"(fr));
        const int row0 = u.pm * 256 + wr * 64 + fr, col0 = u.pn * 256 + wc * 32 + 8 * fq;
#pragma unroll
        for (int ai = 0; ai < 2; ++ai)
#pragma unroll
            for (int m = 0; m < 4; ++m) { const size_t ro = (size_t)(row0 + ai * 128 + m * 16) * DM + col0;
#pragma unroll
                for (int bj = 0; bj < 2; ++bj) { const size_t o = ro + bj * 128;
                    const u32x4 gq = *(const u32x4*)(gm + o);
                    const f32x4 v0 = acc[ai][bj][m][0], v1 = acc[ai][bj][m][1];
                    u32x4 w; w.x = cvt_pk_bf16(v0[0] * sigmoidf_(bf_lo(gq.x)), v0[1] * sigmoidf_(bf_hi(gq.x))); w.y = cvt_pk_bf16(v0[2] * sigmoidf_(bf_lo(gq.y)), v0[3] * sigmoidf_(bf_hi(gq.y)));
                    w.z = cvt_pk_bf16(v1[0] * sigmoidf_(bf_lo(gq.z)), v1[1] * sigmoidf_(bf_hi(gq.z))); w.w = cvt_pk_bf16(v1[2] * sigmoidf_(bf_lo(gq.w)), v1[3] * sigmoidf_(bf_hi(gq.w)));
                    *(u32x4*)(O + o) = w; } }
    }
};
template <class Epi> DI void run_gemm(const Ctx cx, LAS unsigned char* lds, const bf16_t* A, const bf16_t* Bt, int N, int K, const Epi& E, const bf16_t* A2 = nullptr, const bf16_t* Bt2 = nullptr) {
    pg8::Gemm g; g.A = A; g.Bt = Bt; g.M = M_TOK; g.N = N; g.K = K; g.A2 = A2; g.Bt2 = Bt2;
    pg8::StaticOrder S; S.init(M_TOK, N, cx.nb, cx.bid);
    pg8::gemm_phase<Epi, pg8::StaticOrder, false>(lds, g, S, E, nullptr, cx.tid);
}

DI void transpose_item(const float* W, int ldw, int sc0, bf16_t* WT, int dr0, int kb, LAS float* scr, int lane) {
    const int k0 = 64 * kb;
    float t[64];
#pragma unroll
    for (int i = 0; i < 64; ++i) t[i] = __builtin_nontemporal_load(W + (size_t)(k0 + i) * ldw + sc0 + lane);
#pragma unroll
    for (int i = 0; i < 64; ++i) scr[i * 65 + lane] = t[i];
    asm volatile("s_waitcnt lgkmcnt(0)" ::: "memory");
    const int c = lane & 7;
#pragma unroll
    for (int j = 0; j < 8; ++j) { const int n = (lane >> 3) + 8 * j; const LAS float* s = scr + (8 * c) * 65 + n;
        u32x4 o; o.x = cvt_pk_bf16(s[0 * 65], s[1 * 65]); o.y = cvt_pk_bf16(s[2 * 65], s[3 * 65]); o.z = cvt_pk_bf16(s[4 * 65], s[5 * 65]); o.w = cvt_pk_bf16(s[6 * 65], s[7 * 65]);
        *(u32x4*)(WT + (size_t)(dr0 + n) * DM + k0 + 8 * c) = o; }
    asm volatile("s_waitcnt lgkmcnt(0)" ::: "memory");
}
DI float reduce16_cols(const f32x4 (&a)[4], int lane) {
    float t8[8];
#pragma unroll
    for (int c = 0; c < 8; ++c) { const float lo = a[c >> 2][c & 3], hi = a[(c + 8) >> 2][c & 3]; const bool up = (lane & 32) != 0;
        const float keep = up ? hi : lo, give = up ? lo : hi; t8[c] = keep + __shfl_xor(give, 32); }
    float t4[4];
#pragma unroll
    for (int c = 0; c < 4; ++c) { const bool up = (lane & 16) != 0; const float keep = up ? t8[c + 4] : t8[c], give = up ? t8[c] : t8[c + 4]; t4[c] = keep + __shfl_xor(give, 16); }
    float t2[2];
#pragma unroll
    for (int c = 0; c < 2; ++c) { const bool up = (lane & 8) != 0; const float keep = up ? t4[c + 2] : t4[c], give = up ? t4[c] : t4[c + 2]; t2[c] = keep + __shfl_xor(give, 8); }
    const bool up = (lane & 4) != 0; const float keep = up ? t2[1] : t2[0], give = up ? t2[0] : t2[1];
    float t1 = keep + __shfl_xor(give, 4);
    t1 += __shfl_xor(t1, 2); t1 += __shfl_xor(t1, 1);
    return t1;
}
DI void ph_prep(const Ctx cx, const Params& p, LAS unsigned char* lds) {
    const int tid = cx.tid, wave = tid >> 6, lane = tid & 63;
    const int gw = cx.bid * 8 + wave, NGW = cx.nb * 8;
    constexpr int PREP_RB = 5;
    const bool split = cx.nb == 256; const int xcd_ = cx.bid & 7, jb = cx.bid >> 3, grp8 = xcd_ * 4 + (jb >> 3), r8 = jb & 7;
    const bool do_rows = !split || r8 < PREP_RB, do_tr = !split || r8 >= PREP_RB;
    const int gwr = split ? (grp8 * PREP_RB + r8) * 8 + wave : gw, NGWR = split ? 32 * PREP_RB * 8 : NGW;
    const int NGWT = split ? 32 * (8 - PREP_RB) * 8 : NGW;
    bf16_t* hn = (bf16_t*)p.out;
    float* ig = (float*)(p.ws + WS_GATES); float* lf = ig + M_TOK * 8;
    if (do_rows) {
    f32x4 na[8], nb2[8];
#define PR_LOAD(pr_) do { const f32x4* xr_ = (const f32x4*)(p.x + (size_t)(2 * (pr_)) * DM) + lane; \
        _Pragma("unroll") for (int j = 0; j < 8; ++j) { na[j] = __builtin_nontemporal_load(xr_ + 64 * j); nb2[j] = __builtin_nontemporal_load(xr_ + 512 + 64 * j); } } while (0)
    if (gwr < M_TOK / 2) PR_LOAD(gwr);
#pragma unroll
    for (int i = 0; i < 16; ++i) { const int idx = tid + 512 * i, l = idx & 63, rest = idx >> 6, c4 = rest & 3, e = (rest >> 2) & 3, j = rest >> 4;
        *(LAS f32x4*)(lds + (size_t)idx * 16) = *(const f32x4*)(p.w_in + (size_t)(256 * j + 4 * l + e) * INW + 12288 + 4 * c4); }
    __syncthreads();
    for (int pr = gwr; pr < M_TOK / 2; pr += NGWR) {
        const int row = 2 * pr;
        f32x4 va[8], vb[8]; float sa = 0.f, sb = 0.f;
#pragma unroll
        for (int j = 0; j < 8; ++j) { va[j] = na[j]; vb[j] = nb2[j]; }
        const int prn = (pr + NGWR < M_TOK / 2) ? pr + NGWR : pr;
        const f32x4* xrn = (const f32x4*)(p.x + (size_t)(2 * prn) * DM) + lane;
#pragma unroll
        for (int j = 0; j < 8; ++j) { sa += (va[j].x * va[j].x + va[j].y * va[j].y) + (va[j].z * va[j].z + va[j].w * va[j].w);
            sb += (vb[j].x * vb[j].x + vb[j].y * vb[j].y) + (vb[j].z * vb[j].z + vb[j].w * vb[j].w); }
        sa = wave_sum(sa); sb = wave_sum(sb);
        const float rstda = rsqrtf(sa * (1.f / DM) + 1e-6f), rstdb = rsqrtf(sb * (1.f / DM) + 1e-6f);
        f32x4 acca[4], accb[4];
#pragma unroll
        for (int c = 0; c < 4; ++c) { acca[c] = (f32x4){0.f, 0.f, 0.f, 0.f}; accb[c] = (f32x4){0.f, 0.f, 0.f, 0.f}; }
#pragma unroll
        for (int j = 0; j < 8; ++j) {
            const f32x4 g4 = ((const f32x4*)p.norm_g)[64 * j + lane];
            const f32x4 ha = (va[j] * rstda) * g4, hb = (vb[j] * rstdb) * g4;
            na[j] = __builtin_nontemporal_load(xrn + 64 * j); nb2[j] = __builtin_nontemporal_load(xrn + 512 + 64 * j);
            u32x2 pk; pk.x = cvt_pk_bf16(ha.x, ha.y); pk.y = cvt_pk_bf16(ha.z, ha.w);
            *(u32x2*)(hn + (size_t)row * DM + 256 * j + 4 * lane) = pk;
            pk.x = cvt_pk_bf16(hb.x, hb.y); pk.y = cvt_pk_bf16(hb.z, hb.w);
            *(u32x2*)(hn + (size_t)(row + 1) * DM + 256 * j + 4 * lane) = pk;
#pragma unroll
            for (int e = 0; e < 4; ++e) {
#pragma unroll
                for (int c4 = 0; c4 < 4; ++c4) { const f32x4 w = *(const LAS f32x4*)(lds + (size_t)((((j * 4 + e) * 4 + c4) * 64) + lane) * 16);
                    acca[c4] += ha[e] * w; accb[c4] += hb[e] * w; }
                if (e & 1) asm volatile("" ::: "memory"); }
        }
        const float suma = reduce16_cols(acca, lane), sumb = reduce16_cols(accb, lane);
        if ((lane & 3) == 0) { const int col = ((lane >> 5) & 1) * 8 + ((lane >> 4) & 1) * 4 + ((lane >> 3) & 1) * 2 + ((lane >> 2) & 1);
            const float za = suma + p.b_if[col], zb = sumb + p.b_if[col];
            if (col < 8) { ig[(size_t)row * 8 + col] = za; ig[(size_t)(row + 1) * 8 + col] = zb; }
            else { lf[(size_t)row * 8 + col - 8] = fminf(za, 0.f) - log1pf(__expf(-fabsf(za))); lf[(size_t)(row + 1) * 8 + col - 8] = fminf(zb, 0.f) - log1pf(__expf(-fabsf(zb))); } }
    }
#undef PR_LOAD
    }
    __syncthreads();
    if (do_tr) {
    int lane_t = lane, wave_t = wave; asm volatile("" : "+v"(lane_t), "+v"(wave_t));
    LAS float* scr = (LAS float*)(lds + wave_t * 16640);
    constexpr int I_IN = 32 * 320, I_SQ = 32 * 32, NIT = I_IN + 3 * I_SQ;
    const int gwt = split ? (grp8 * (8 - PREP_RB) + (r8 - PREP_RB)) * 8 + wave_t : cx.bid * 8 + wave_t;
    for (int it = gwt; it < NIT; it += NGWT) {
        if (it < I_IN) { const int kb = it / 320, nb = it % 320, n0 = 64 * nb;
            transpose_item(p.w_in, INW, n0 < 12288 ? n0 : n0 + 16, (bf16_t*)(p.ws + WS_WINT), n0, kb, scr, lane_t); }
        else { int r = it - I_IN; const int which = r / I_SQ; r -= which * I_SQ; const int kb = r >> 5, nb = r & 31;
            const float* W = which == 0 ? p.w_attn : (which == 1 ? p.w_mlstm : p.w_out);
            bf16_t* WT = (bf16_t*)(p.ws + (which == 0 ? WS_WA : (which == 1 ? WS_WM : WS_WO)));
            transpose_item(W, DM, 64 * nb, WT, 64 * nb, kb, scr, lane_t); }
    }
    }
}

DI void ph_attn(const Ctx cx, const Params& p, LAS unsigned char* lds) {
    const bf16_t* Qg = slot(p, 0); const bf16_t* Kg = slot(p, 1); const bf16_t* Vg = slot(p, 2);
    float* lse = (float*)(p.ws + WS_LSE);
    const int tid = cx.tid, wave = __builtin_amdgcn_readfirstlane(tid >> 6), lane = tid & 63, fr = lane & 15, g = lane >> 4, q4 = fr >> 2, p4 = fr & 3;
    constexpr int RS = 272, VRS = 288;
    LAS unsigned char* Ks = lds; LAS unsigned char* Vs = lds + 256 * RS;
    const int i0 = wave * 16, w0 = i0 < 96 ? i0 : 96;
    u32x4 pk[8], pv[8]; bf16x8 qf[4];
    const bool fast = cx.nb == 256; const int xcd = cx.bid & 7, cuix = cx.bid >> 3, nit = fast ? 24 : (6144 - cx.bid + cx.nb - 1) / cx.nb;
#define ATT_ITEM(i) (fast ? (((((xcd * 8 + (i) / 3) * 3 + (i) % 3)) << 5) | ((cuix + (i)) & 31)) : cx.bid + (i) * cx.nb)
#define ATT_DECODE(itx) const int blk = (itx) & 31, rest = (itx) >> 5, pat = rest % 3, bh = rest / 3, h = bh & 15, b = bh >> 4; \
        const int sh = 2 * pat, r = 1 << sh, nblk = 32 >> sh, php = blk >> (5 - sh), n = blk & (nblk - 1); const size_t tok0 = (size_t)b * SEQ;
#define ATT_LOADKV(itx) do { ATT_DECODE(itx) \
        _Pragma("unroll") for (int i = 0; i < 8; ++i) { const int idx = tid + 512 * i, row = idx >> 4, ch = idx & 15; int uu = (n - 1) * 128 + row; uu = uu < 0 ? 0 : uu; \
            const size_t go = (tok0 + (size_t)uu * r + php) * DM + h * 128 + ch * 8; pk[i] = *(const u32x4*)(Kg + go); pv[i] = *(const u32x4*)(Vg + go); } } while (0)
#define ATT_LOADQ(itx) do { ATT_DECODE(itx) \
        const size_t tq = tok0 + (size_t)(n * 128 + i0 + fr) * r + php; const bf16_t* qp = Qg + tq * DM + h * 128 + 8 * g; \
        _Pragma("unroll") for (int ks = 0; ks < 4; ++ks) qf[ks] = *(const bf16x8*)(qp + 32 * ks); } while (0)
    if (nit > 0) { ATT_LOADKV(ATT_ITEM(0)); ATT_LOADQ(ATT_ITEM(0)); }
    for (int ii = 0; ii < nit; ++ii) {
        const int it = ATT_ITEM(ii), itn = ATT_ITEM(ii + 1);
        ATT_DECODE(it)
        lds_barrier();
#pragma unroll
        for (int i = 0; i < 8; ++i) { const int idx = tid + 512 * i, row = idx >> 4, ch = idx & 15;
            *(LAS u32x4*)(Ks + row * RS + ch * 16) = pk[i]; *(LAS u32x4*)(Vs + row * VRS + ch * 16) = pv[i]; }
        lds_barrier();
        if (ii + 1 < nit) ATT_LOADKV(itn);
        const int ktlo = n > 0 ? 0 : ((128 - w0) >> 4);
        const int koffr = (i0 - w0) >> 4;
        float mx = -INFINITY, den = 0.f; f32x4 oacc[8];
        {
            const float c1 = 0.08838834764831845f * 1.4426950408889634f, sl2 = exp2f(-0.5f * (float)(h + 1)) * (float)r * 1.4426950408889634f;
            int lv = lane; asm volatile("" : "+v"(lv));
            const int e0 = (lv & 15) - 4 * (lv >> 4);
            float ae[4];
#pragma unroll
            for (int jj = 0; jj < 4; ++jj) ae[jj] = -sl2 * (float)(e0 - jj);
            f32x4 sacc[10];
            LAS unsigned char* kbase = Ks + (w0 + 16 * koffr + fr) * RS + 16 * g;
            bf16x8 kfb[2][4];
#pragma unroll
            for (int ks = 0; ks < 4; ++ks) kfb[0][ks] = *(const LAS bf16x8*)(kbase + 64 * ks);
            sacc[9] = (f32x4){0.f, 0.f, 0.f, 0.f};
#pragma unroll
            for (int i = 0; i < 9; ++i) {
                if (i + 1 < 9) {
#pragma unroll
                    for (int ks = 0; ks < 4; ++ks) kfb[(i + 1) & 1][ks] = *(const LAS bf16x8*)(kbase + 16 * (i + 1) * RS + 64 * ks); }
                f32x4 a = (f32x4){0.f, 0.f, 0.f, 0.f};
#pragma unroll
                for (int ks = 0; ks < 4; ++ks) a = mfma16(kfb[i & 1][ks], qf[ks], a);
                const float tc = (koffr + i < ktlo) ? -INFINITY : sl2 * (float)(16 * i - 128);
#pragma unroll
                for (int jj = 0; jj < 4; ++jj) { float sv = fmaf(a[jj], c1, ae[jj] + tc);
                    if (i == 0) sv = (e0 - jj <= 0) ? sv : -INFINITY;
                    if (i == 8) sv = (e0 - jj >= 0) ? sv : -INFINITY;
                    a[jj] = sv; mx = fmaxf(mx, sv); }
                sacc[i] = a;
                asm volatile("" ::: "memory"); }
            if (ii + 1 < nit) ATT_LOADQ(itn);
            mx = fmaxf(mx, __shfl_xor(mx, 16)); mx = fmaxf(mx, __shfl_xor(mx, 32));
#pragma unroll
            for (int i = 0; i < 9; ++i)
#pragma unroll
                for (int jj = 0; jj < 4; ++jj) { const float pe = __builtin_amdgcn_exp2f(sacc[i][jj] - mx); den += pe; sacc[i][jj] = pe; }
            den += __shfl_xor(den, 16); den += __shfl_xor(den, 32);
#pragma unroll
            for (int dt = 0; dt < 8; ++dt) oacc[dt] = (f32x4){0.f, 0.f, 0.f, 0.f};
            LAS unsigned char* vbase = Vs + (w0 + 16 * koffr + 4 * g + q4) * VRS + 8 * p4;
            bf16x8 vfb[2][2]; bf16x8 pf;
#pragma unroll
            for (int d = 0; d < 2; ++d) vfb[0][d] = tr8(vbase + 32 * d, vbase + 32 * d + 16 * VRS);
#pragma unroll
            for (int u = 0; u < 20; ++u) { const int ks2 = u >> 2, qtr = u & 3;
                if (u + 1 < 20) { const int k2n = (u + 1) >> 2, qn = (u + 1) & 3; LAS unsigned char* vb = vbase + 32 * k2n * VRS;
#pragma unroll
                    for (int d = 0; d < 2; ++d) vfb[(u + 1) & 1][d] = tr8(vb + 32 * (2 * qn + d), vb + 32 * (2 * qn + d) + (k2n == 4 ? 0 : 16 * VRS)); }
                if (qtr == 0) { u32x4 pw; pw.x = cvt_pk_bf16(sacc[2 * ks2][0], sacc[2 * ks2][1]); pw.y = cvt_pk_bf16(sacc[2 * ks2][2], sacc[2 * ks2][3]);
                    pw.z = cvt_pk_bf16(sacc[2 * ks2 + 1][0], sacc[2 * ks2 + 1][1]); pw.w = cvt_pk_bf16(sacc[2 * ks2 + 1][2], sacc[2 * ks2 + 1][3]);
                    pf = __builtin_bit_cast(bf16x8, pw); }
#pragma unroll
                for (int d = 0; d < 2; ++d) oacc[2 * qtr + d] = mfma16(vfb[u & 1][d], pf, oacc[2 * qtr + d]);
                asm volatile("" ::: "memory"); }
        }
        const float inv = 1.f / den;
        const size_t tqo = tok0 + (size_t)(n * 128 + i0 + fr) * r + php;
        bf16_t* op = slot(p, 4 + pat) + tqo * DM + h * 128 + 4 * g;
#pragma unroll
        for (int dt = 0; dt < 8; ++dt) { u32x2 w; w.x = cvt_pk_bf16(oacc[dt][0] * inv, oacc[dt][1] * inv); w.y = cvt_pk_bf16(oacc[dt][2] * inv, oacc[dt][3] * inv);
            *(u32x2*)(op + 16 * dt) = w; }
        if (g == 0) lse[(size_t)pat * M_TOK * 16 + tqo * 16 + h] = (mx + __log2f(den)) * 0.6931471805599453f;
    }
#undef ATT_LOADKV
#undef ATT_ITEM
#undef ATT_LOADQ
#undef ATT_DECODE
}

DI void ph_comb(const Ctx cx, const Params& p) {
    const bf16_t* O0 = slot(p, 4); const bf16_t* O1 = slot(p, 5); const bf16_t* O2 = slot(p, 6); const bf16_t* Z = slot(p, 3);
    bf16_t* AG = slot(p, 7);
    const float* lse = (const float*)(p.ws + WS_LSE);
    const size_t nth = (size_t)cx.nb * 512, total = (size_t)M_TOK * 256;
    for (size_t idx0 = (size_t)cx.bid * 512 + cx.tid; idx0 < total; idx0 += 2 * nth) {
        u32x4 a0[2], a1[2], a2[2], z[2]; float l0[2], l1[2], l2[2]; size_t o[2]; bool ok[2];
#pragma unroll
        for (int q = 0; q < 2; ++q) { const size_t idx = idx0 + q * nth; ok[q] = idx < total; const size_t ix = ok[q] ? idx : idx0;
            const size_t m = ix >> 8; const int c8 = (int)(ix & 255), h = c8 >> 4; o[q] = m * DM + c8 * 8;
            l0[q] = lse[m * 16 + h]; l1[q] = lse[(size_t)M_TOK * 16 + m * 16 + h]; l2[q] = lse[(size_t)2 * M_TOK * 16 + m * 16 + h];
            a0[q] = __builtin_nontemporal_load((const u32x4*)(O0 + o[q])); a1[q] = __builtin_nontemporal_load((const u32x4*)(O1 + o[q])); a2[q] = __builtin_nontemporal_load((const u32x4*)(O2 + o[q])); z[q] = __builtin_nontemporal_load((const u32x4*)(Z + o[q])); }
#pragma unroll
        for (int q = 0; q < 2; ++q) {
            const float mxl = fmaxf(l0[q], fmaxf(l1[q], l2[q]));
            float w0 = __expf(l0[q] - mxl), w1 = __expf(l1[q] - mxl), w2 = __expf(l2[q] - mxl);
            const float inv = 1.f / (w0 + w1 + w2); w0 *= inv; w1 *= inv; w2 *= inv;
            u32x4 res;
#pragma unroll
            for (int e2 = 0; e2 < 4; ++e2) {
                const float lo = (w0 * bf_lo(a0[q][e2]) + w1 * bf_lo(a1[q][e2]) + w2 * bf_lo(a2[q][e2])) * siluf_(bf_lo(z[q][e2]));
                const float hi = (w0 * bf_hi(a0[q][e2]) + w1 * bf_hi(a1[q][e2]) + w2 * bf_hi(a2[q][e2])) * siluf_(bf_hi(z[q][e2]));
                res[e2] = cvt_pk_bf16(lo, hi); }
            if (ok[q]) __builtin_nontemporal_store(res, (u32x4*)(AG + o[q])); }
    }
}

DI void ph_conv(const Ctx cx, const Params& p) {
    const bf16_t* U = slot(p, 0); bf16_t* QK = slot(p, 4);
    const size_t nth = (size_t)cx.nb * 512;
    for (size_t idx = (size_t)cx.bid * 512 + cx.tid; idx < (size_t)(M_TOK / 8) * 256; idx += nth) {
        const int c8 = (int)(idx & 255); const size_t t0 = (idx >> 8) * 8; const bool first = (t0 & (SEQ - 1)) == 0;
        float w[4][8], bias[8];
#pragma unroll
        for (int j = 0; j < 4; ++j) { const f32x4 a = *(const f32x4*)(p.conv_w + j * DM + c8 * 8), b2 = *(const f32x4*)(p.conv_w + j * DM + c8 * 8 + 4);
            w[j][0] = a.x; w[j][1] = a.y; w[j][2] = a.z; w[j][3] = a.w; w[j][4] = b2.x; w[j][5] = b2.y; w[j][6] = b2.z; w[j][7] = b2.w; }
        { const f32x4 a = *(const f32x4*)(p.conv_b + c8 * 8), b2 = *(const f32x4*)(p.conv_b + c8 * 8 + 4);
          bias[0] = a.x; bias[1] = a.y; bias[2] = a.z; bias[3] = a.w; bias[4] = b2.x; bias[5] = b2.y; bias[6] = b2.z; bias[7] = b2.w; }
        float u[11][8];
#pragma unroll
        for (int t = 0; t < 11; ++t) { u32x4 raw = (u32x4){0u, 0u, 0u, 0u};
            if (t >= 3 || !first) raw = *(const u32x4*)(U + (t0 + t - 3) * DM + c8 * 8);
#pragma unroll
            for (int e = 0; e < 4; ++e) { u[t][2 * e] = bf_lo(raw[e]); u[t][2 * e + 1] = bf_hi(raw[e]); } }
        const float osc = c8 >= 128 ? 0.08838834764831845f : 1.f;
#pragma unroll
        for (int t = 0; t < 8; ++t) { float y[8];
#pragma unroll
            for (int e = 0; e < 8; ++e) { float a = bias[e];
#pragma unroll
                for (int j = 0; j < 4; ++j) a += w[j][e] * u[t + j][e];
                y[e] = siluf_(a) * osc; }
            u32x4 res; res.x = cvt_pk_bf16(y[0], y[1]); res.y = cvt_pk_bf16(y[2], y[3]); res.z = cvt_pk_bf16(y[4], y[5]); res.w = cvt_pk_bf16(y[6], y[7]);
            *(u32x4*)(QK + (t0 + t) * DM + c8 * 8) = res; }
    }
}

DI void ph_mlstm(const Ctx cx, const Params& p, LAS unsigned char* lds) {
    const bf16_t* QK = slot(p, 4); const bf16_t* Vg = slot(p, 1); bf16_t* Hb = slot(p, 5);
    const float* igp = (const float*)(p.ws + WS_GATES); const float* lfp = igp + M_TOK * 8;
    const int tid = cx.tid, wave = __builtin_amdgcn_readfirstlane(tid >> 6), lane = tid & 63, fr = lane & 15, g = lane >> 4, q4 = fr >> 2, p4 = fr & 3;
    constexpr int RS = 272, VS = 112, BUF = 56576, O_Q = 0, O_K = 17408, O_V = 34816, O_C = 41984, O_G = 55040;
    constexpr int O_TB = 2 * BUF;
    const int tt = wave >> 1, wb = wave & 1;
    const u32x4 zero4 = (u32x4){0u, 0u, 0u, 0u};
    for (int item = cx.bid; item < 256; item += cx.nb) {
        int bhi = item >> 3, dvs = item & 7;
        if (cx.nb == 256) { bhi = (item & 7) * 4 + (item >> 6); dvs = (item >> 3) & 7; }
        const int b = bhi >> 3, h = bhi & 7;
        const size_t tok0 = (size_t)b * SEQ;
        __syncthreads();
        if (tid < 256) { const int bsel = tid >> 7, row = (tid >> 1) & 63, hf = tid & 1;
            *(LAS u32x4*)(lds + bsel * BUF + O_V + row * VS + 64 + hf * 16) = hf ? zero4 : (u32x4){0x3F80u, 0u, 0u, 0u}; }
        for (int i = tid; i < 816; i += 512) *(LAS u32x4*)(lds + O_C + i * 16) = zero4;
        f32x4 C[3];
#pragma unroll
        for (int ct = 0; ct < 3; ++ct) C[ct] = (f32x4){0.f, 0.f, 0.f, 0.f};
        float m_st = 0.f;
        struct PFSet { u32x4 q[2], k[2], v; };
        PFSet s0, s1; s0.v = zero4; s1.v = zero4;
        float gi = 0.f, gl = 0.f;
        const int prow = tid >> 4, pch = tid & 15;
#define ML_PREFETCH(S, cc) do { const size_t tb = tok0 + (size_t)(cc) * 64; \
            S.q[0] = *(const u32x4*)(QK + (tb + prow) * DM + h * 128 + pch * 8); S.q[1] = *(const u32x4*)(QK + (tb + prow + 32) * DM + h * 128 + pch * 8); \
            S.k[0] = *(const u32x4*)(QK + (tb + prow) * DM + 1024 + h * 128 + pch * 8); S.k[1] = *(const u32x4*)(QK + (tb + prow + 32) * DM + 1024 + h * 128 + pch * 8); \
            if (tid < 256) S.v = *(const u32x4*)(Vg + (tb + (tid >> 2)) * DM + h * 256 + dvs * 32 + (tid & 3) * 8); \
            } while (0)
#define ML_STORE(S, bp) do { LAS unsigned char* bp_ = (bp); \
            *(LAS u32x4*)(bp_ + O_Q + prow * RS + pch * 16) = S.q[0]; *(LAS u32x4*)(bp_ + O_Q + (prow + 32) * RS + pch * 16) = S.q[1]; \
            *(LAS u32x4*)(bp_ + O_K + prow * RS + pch * 16) = S.k[0]; *(LAS u32x4*)(bp_ + O_K + (prow + 32) * RS + pch * 16) = S.k[1]; \
            if (tid < 256) *(LAS u32x4*)(bp_ + O_V + (tid >> 2) * VS + (tid & 3) * 16) = S.v; } while (0)
#define ML_GLOAD(cc) do { const size_t tb = tok0 + (size_t)(cc) * 64; gi = igp[(tb + lane) * 8 + h]; gl = lfp[(tb + lane) * 8 + h]; } while (0)
#define ML_SCAN(cc) do { LAS float* tb_ = (LAS float*)(lds + O_TB) + ((cc) & 15) * 192; float bcs = gl; \
            _Pragma("unroll") for (int o = 1; o < 64; o <<= 1) { const float t_ = __shfl_up(bcs, o); if (lane >= o) bcs += t_; } \
            const float uu = gi - bcs; float cmx = uu; \
            _Pragma("unroll") for (int o = 1; o < 64; o <<= 1) { const float t_ = __shfl_up(cmx, o); if (lane >= o) cmx = fmaxf(cmx, t_); } \
            tb_[lane] = uu; tb_[64 + lane] = cmx; tb_[128 + lane] = bcs; } while (0)
#define ML_GATES(cc, bp) do { if (wave == 0) { const LAS float* tb_ = (const LAS float*)(lds + O_TB) + ((cc) & 15) * 192; LAS float* ga_ = (LAS float*)((bp) + O_G); \
            const float uu = tb_[lane], cmx = tb_[64 + lane], bcs = tb_[128 + lane]; \
            const float cm = fmaxf(m_st, cmx), mt = bcs + cm; \
            const float b_last = __int_as_float(__builtin_amdgcn_readlane(__float_as_int(bcs), 63)), cm63 = __int_as_float(__builtin_amdgcn_readlane(__float_as_int(cm), 63)); \
            ga_[lane] = uu; ga_[64 + lane] = cm; ga_[128 + lane] = __expf(m_st - cm); ga_[192 + lane] = __expf(-mt); ga_[256 + lane] = __expf(uu - cm63); \
            if (lane == 0) ga_[320] = __expf(m_st - cm63); \
            m_st = b_last + cm63; } } while (0)
        ML_GLOAD(wave); ML_SCAN(wave); ML_GLOAD(8 + wave); ML_SCAN(8 + wave);
        __syncthreads();
        ML_PREFETCH(s0, 0); ML_PREFETCH(s1, 1);
        ML_STORE(s0, lds); ML_GATES(0, lds);
        ML_PREFETCH(s0, 2);
        __syncthreads();
        for (int c2 = 0; c2 < 64; c2 += 2) {
#pragma unroll
          for (int hc = 0; hc < 2; ++hc) {
            const int c = c2 + hc;
            LAS unsigned char* cur = lds + hc * BUF; LAS unsigned char* nxt = lds + (hc ^ 1) * BUF;
            if (hc == 0) { if (c + 1 < 64) { ML_STORE(s1, nxt); ML_GATES(c + 1, nxt); if (c + 3 < 64) ML_PREFETCH(s1, c + 3); } }
            else { if (c + 1 < 64) { ML_STORE(s0, nxt); ML_GATES(c + 1, nxt); if (c + 3 < 64) ML_PREFETCH(s0, c + 3); } }
            if ((c & 7) == 0 && c + 16 + wave < 64) ML_GLOAD(c + 16 + wave);
            if ((c & 7) == 7 && c + 9 + wave < 64) ML_SCAN(c + 9 + wave);
            LAS unsigned char* qs = cur + O_Q; LAS unsigned char* ks = cur + O_K; LAS unsigned char* vs = cur + O_V; LAS unsigned char* cbs = cur + O_C;
            const LAS float* ga = (const LAS float*)(cur + O_G);
            const int t = 16 * tt + fr;
            const float cm_t = ga[64 + t], wi_t = ga[128 + t], emt_t = ga[192 + t];
            bf16x8 qf[4];
#pragma unroll
            for (int k4 = 0; k4 < 4; ++k4) qf[k4] = *(const LAS bf16x8*)(qs + t * RS + (32 * k4 + 8 * g) * 2);
            f32x4 sT[4];
#pragma unroll
            for (int st = 0; st < 4; ++st) { sT[st] = (f32x4){0.f, 0.f, 0.f, 0.f};
                if (st <= tt) {
#pragma unroll
                    for (int k4 = 0; k4 < 4; ++k4) { const bf16x8 kf = *(const LAS bf16x8*)(ks + (16 * st + fr) * RS + (32 * k4 + 8 * g) * 2); sT[st] = mfma16(kf, qf[k4], sT[st]); }
                    const f32x4 u4 = *(const LAS f32x4*)(ga + 16 * st + 4 * g);
#pragma unroll
                    for (int jj = 0; jj < 4; ++jj) { const int s = 16 * st + 4 * g + jj; sT[st][jj] *= (s <= t) ? __expf(u4[jj] - cm_t) : 0.f; } } }
            f32x4 nA = (f32x4){0.f, 0.f, 0.f, 0.f}, nD = nA, iA = nA, iD = nA;
#pragma unroll
            for (int k2 = 0; k2 < 2; ++k2) {
                if (2 * k2 <= tt) {
                    u32x4 sw; sw.x = cvt_pk_bf16(sT[2 * k2][0], sT[2 * k2][1]); sw.y = cvt_pk_bf16(sT[2 * k2][2], sT[2 * k2][3]);
                    sw.z = cvt_pk_bf16(sT[2 * k2 + 1][0], sT[2 * k2 + 1][1]); sw.w = cvt_pk_bf16(sT[2 * k2 + 1][2], sT[2 * k2 + 1][3]);
                    const bf16x8 scf = __builtin_bit_cast(bf16x8, sw);
                    LAS unsigned char* vb = vs + (32 * k2 + 4 * g + q4) * VS + 8 * p4;
                    const bf16x8 vA = tr8(vb + 32 * wb, vb + 32 * wb + 16 * VS);
                    const bf16x8 vD = tr8(vb + 64, vb + 64 + 16 * VS);
                    nA = mfma16(vA, scf, nA); nD = mfma16(vD, scf, nD); } }
#pragma unroll
            for (int k4 = 0; k4 < 4; ++k4) {
                const bf16x8 cA = *(const LAS bf16x8*)(cbs + (16 * wb + fr) * RS + (32 * k4 + 8 * g) * 2);
                const bf16x8 cD = *(const LAS bf16x8*)(cbs + (32 + fr) * RS + (32 * k4 + 8 * g) * 2);
                iA = mfma16(cA, qf[k4], iA); iD = mfma16(cD, qf[k4], iD); }
            {
                float den = wi_t * iD[0] + nD[0];
                den = __shfl(den, fr);
                const float dinv = 1.f / fmaxf(fabsf(den), emt_t);
                u32x2 w; w.x = cvt_pk_bf16((wi_t * iA[0] + nA[0]) * dinv, (wi_t * iA[1] + nA[1]) * dinv); w.y = cvt_pk_bf16((wi_t * iA[2] + nA[2]) * dinv, (wi_t * iA[3] + nA[3]) * dinv);
                *(u32x2*)(Hb + (tok0 + (size_t)c * 64 + t) * DM + h * 256 + dvs * 32 + 16 * wb + 4 * g) = w;
            }
            {
                const float w_old = ga[320];
#pragma unroll
                for (int ct = 0; ct < 3; ++ct) C[ct] *= w_old;
#pragma unroll
                for (int k2 = 0; k2 < 2; ++k2) {
                    LAS unsigned char* kb = ks + (32 * k2 + 8 * g + q4) * RS + (16 * wave + 4 * p4) * 2;
                    const bf16x8 kraw = tr8(kb, kb + 4 * RS);
                    const f32x4 w0 = *(const LAS f32x4*)(ga + 256 + 32 * k2 + 8 * g), w1 = *(const LAS f32x4*)(ga + 256 + 32 * k2 + 8 * g + 4);
                    u32x4 ka;
                    ka.x = cvt_pk_bf16(bf1((bf16_t)kraw[0]) * w0.x, bf1((bf16_t)kraw[1]) * w0.y); ka.y = cvt_pk_bf16(bf1((bf16_t)kraw[2]) * w0.z, bf1((bf16_t)kraw[3]) * w0.w);
                    ka.z = cvt_pk_bf16(bf1((bf16_t)kraw[4]) * w1.x, bf1((bf16_t)kraw[5]) * w1.y); ka.w = cvt_pk_bf16(bf1((bf16_t)kraw[6]) * w1.z, bf1((bf16_t)kraw[7]) * w1.w);
                    const bf16x8 kf = __builtin_bit_cast(bf16x8, ka);
                    LAS unsigned char* vb = vs + (32 * k2 + 8 * g + q4) * VS + 8 * p4;
#pragma unroll
                    for (int ct = 0; ct < 3; ++ct) { const bf16x8 vf = tr8(vb + 32 * ct, vb + 32 * ct + 4 * VS); C[ct] = mfma16(kf, vf, C[ct]); }
                }
#pragma unroll
                for (int ct = 0; ct < 3; ++ct) { u32x2 w; w.x = cvt_pk_bf16(C[ct][0], C[ct][1]); w.y = cvt_pk_bf16(C[ct][2], C[ct][3]);
                    *(LAS u32x2*)(nxt + O_C + (16 * ct + fr) * RS + (16 * wave + 4 * g) * 2) = w; }
            }
            lds_barrier();
          }
        }
#undef ML_PREFETCH
#undef ML_GLOAD
#undef ML_SCAN
#undef ML_GATES
#undef ML_STORE
    }
}

DI void ph_mnorm(const Ctx cx, const Params& p) {
    bf16_t* Hb = slot(p, 5); const bf16_t* MO = slot(p, 2); const bf16_t* MZ = slot(p, 3);
    const int wave = cx.tid >> 6, lane = cx.tid & 63;
    const int gw = cx.bid * 8 + wave, NGW = cx.nb * 8;
    u32x4 hn[4], on[4], zn[4];
#define MN_LOAD(r) do { _Pragma("unroll") for (int j = 0; j < 4; ++j) { const size_t o_ = (size_t)(r) * DM + 512 * j + 8 * lane; \
        hn[j] = __builtin_nontemporal_load((const u32x4*)(Hb + o_)); on[j] = __builtin_nontemporal_load((const u32x4*)(MO + o_)); zn[j] = __builtin_nontemporal_load((const u32x4*)(MZ + o_)); } } while (0)
    if (gw < M_TOK) MN_LOAD(gw);
    for (int row = gw; row < M_TOK; row += NGW) {
        u32x4 hq[4], oq[4], zq[4];
#pragma unroll
        for (int j = 0; j < 4; ++j) { hq[j] = hn[j]; oq[j] = on[j]; zq[j] = zn[j]; }
        if (row + NGW < M_TOK) MN_LOAD(row + NGW);
#pragma unroll
        for (int j = 0; j < 4; ++j) { const size_t o = (size_t)row * DM + 512 * j + 8 * lane;
            float cv[8]; float ss = 0.f;
#pragma unroll
            for (int e2 = 0; e2 < 4; ++e2) { cv[2 * e2] = sigmoidf_(bf_lo(oq[j][e2])) * bf_lo(hq[j][e2]); cv[2 * e2 + 1] = sigmoidf_(bf_hi(oq[j][e2])) * bf_hi(hq[j][e2]);
                ss += cv[2 * e2] * cv[2 * e2] + cv[2 * e2 + 1] * cv[2 * e2 + 1]; }
#pragma unroll
            for (int of = 1; of < 32; of <<= 1) ss += __shfl_xor(ss, of);
            const float rinv = rsqrtf(ss * (1.f / 256.f) + 1e-6f);
            const f32x4 g0 = *(const f32x4*)(p.mnorm_g + 512 * j + 8 * lane), g1 = *(const f32x4*)(p.mnorm_g + 512 * j + 8 * lane + 4);
            u32x4 res;
            res.x = cvt_pk_bf16(cv[0] * rinv * g0.x * siluf_(bf_lo(zq[j].x)), cv[1] * rinv * g0.y * siluf_(bf_hi(zq[j].x)));
            res.y = cvt_pk_bf16(cv[2] * rinv * g0.z * siluf_(bf_lo(zq[j].y)), cv[3] * rinv * g0.w * siluf_(bf_hi(zq[j].y)));
            res.z = cvt_pk_bf16(cv[4] * rinv * g1.x * siluf_(bf_lo(zq[j].z)), cv[5] * rinv * g1.y * siluf_(bf_hi(zq[j].z)));
            res.w = cvt_pk_bf16(cv[6] * rinv * g1.z * siluf_(bf_lo(zq[j].w)), cv[7] * rinv * g1.w * siluf_(bf_hi(zq[j].w)));
            *(u32x4*)(Hb + o) = res; }
    }
#undef MN_LOAD
}

DI void ph_fin(const Ctx cx, const Params& p) {
    const int wave = cx.tid >> 6, lane = cx.tid & 63;
    const int gw = cx.bid * 8 + wave, NGW = cx.nb * 8;
    const bf16_t* DL = slot(p, 3);
    f32x4 xn[8]; u32x2 dn[8];
#define FN_LOAD(r) do { const f32x4* xr_ = (const f32x4*)(p.x + (size_t)(r) * DM) + lane; const u32x2* dr_ = (const u32x2*)(DL + (size_t)(r) * DM) + lane; \
        _Pragma("unroll") for (int j = 0; j < 8; ++j) { xn[j] = __builtin_nontemporal_load(xr_ + 64 * j); dn[j] = __builtin_nontemporal_load(dr_ + 64 * j); } } while (0)
    if (gw < M_TOK) FN_LOAD(gw);
    for (int row = gw; row < M_TOK; row += NGW) {
        f32x4* orow = (f32x4*)(p.out + (size_t)row * DM) + lane;
        f32x4 v[8]; float s = 0.f;
#pragma unroll
        for (int j = 0; j < 8; ++j) { v[j] = xn[j]; v[j].x += bf_lo(dn[j].x); v[j].y += bf_hi(dn[j].x); v[j].z += bf_lo(dn[j].y); v[j].w += bf_hi(dn[j].y); }
        if (row + NGW < M_TOK) FN_LOAD(row + NGW);
#pragma unroll
        for (int j = 0; j < 8; ++j) s += (v[j].x * v[j].x + v[j].y * v[j].y) + (v[j].z * v[j].z + v[j].w * v[j].w);
        s = wave_sum(s);
        const float rstd = rsqrtf(s * (1.f / DM) + 1e-6f);
#pragma unroll
        for (int j = 0; j < 8; ++j) { const f32x4 g4 = ((const f32x4*)p.final_g)[64 * j + lane]; orow[64 * j] = (v[j] * rstd) * g4; }
    }
#undef FN_LOAD
}

__global__ void __launch_bounds__(512, 2) hybrid_block_fwd(Params p) {
    extern __shared__ __attribute__((aligned(16))) unsigned char shm[];
    LAS unsigned char* lds = (LAS unsigned char*)shm;
    cg::grid_group grid = cg::this_grid();
    if (threadIdx.x < 4) ((volatile LAS unsigned*)(lds + 143360))[threadIdx.x] = 0u;
    __syncthreads();
    if (blockIdx.x == 0) { unsigned* bw = (unsigned*)(p.ws + WS_BAR); for (int i = threadIdx.x; i < XCD_BAR_WORDS; i += 512) bw[i] = 0u; }
    XcdBarrier xb; xb.bar = (unsigned*)(p.ws + WS_BAR); xb.x = 0u; xb.st = (volatile LAS unsigned*)(lds + 143360);
    for (int ph = p.ph_lo; ph < p.ph_hi; ++ph) {
        if (ph == 8 || ph == 10) continue;
        if (ph > p.ph_lo) { if (ph == p.ph_lo + 1) { grid.sync(); xb = xcd_barrier_post((unsigned*)(p.ws + WS_BAR), (volatile LAS unsigned*)(lds + 143360)); } else xcd_barrier(xb); }
#ifdef EXTRA_SYNCS
        if (ph == 3) { for (int i = 0; i < EXTRA_SYNCS; ++i) grid.sync(); }
#endif
#ifndef ONLY_PHASE
#define ONLY_PHASE -1
#endif
#ifndef REPEAT_PHASE
#define REPEAT_PHASE -1
#endif
        for (int rep = 0; rep < (ph == REPEAT_PHASE ? 2 : 1); ++rep) {
        if (rep) { if (ph == p.ph_lo) grid.sync(); else xcd_barrier(xb); }
        Ctx cx; cx.tid = threadIdx.x; cx.bid = blockIdx.x; cx.nb = gridDim.x;
        asm volatile("" : "+v"(cx.tid)); asm volatile("" : "+s"(cx.bid)); asm volatile("" : "+s"(cx.nb));
#define PHEN(k) (ONLY_PHASE < 0 || ONLY_PHASE == (k))
        switch (ph) {
        case 0: if (PHEN(0)) ph_prep(cx, p, lds); break;
        case 1: case 4: if (PHEN(1)) {
            const int grp = ph == 1 ? 0 : 1;
            EpiSplitBf16T<true> E; E.O = slot(p, 0); E.seg_stride = SLOT / 2; E.O4 = slot(p, 6); E.O5 = (bf16_t*)p.out + (size_t)32 * 1024 * 1024;
            run_gemm(cx, lds, (const bf16_t*)p.out, (const bf16_t*)(p.ws + WS_WINT) + (size_t)grp * 8192 * DM, grp == 1 ? 12288 : 8192, DM, E);
        } break;
        case 2: if (PHEN(2)) ph_attn(cx, p, lds); break;
        case 3: if (PHEN(3)) ph_comb(cx, p); break;
        case 5: if (PHEN(5)) ph_conv(cx, p); break;
        case 6: if (PHEN(6)) ph_mlstm(cx, p, lds); break;
        case 7: if (PHEN(7)) ph_mnorm(cx, p); break;
        case 9: if (PHEN(9)) { EpiMerge2 E; E.ga = slot(p, 6); E.gm = (const bf16_t*)p.out + (size_t)32 * 1024 * 1024; E.O = slot(p, 2);
            run_gemm(cx, lds, slot(p, 7), (const bf16_t*)(p.ws + WS_WA), DM, DM, E, slot(p, 5), (const bf16_t*)(p.ws + WS_WM)); } break;
        case 11: if (PHEN(11)) { EpiSplitBf16T<false> E; E.O = slot(p, 3); E.seg_stride = 0; E.O4 = nullptr; E.O5 = nullptr;
            run_gemm(cx, lds, slot(p, 2), (const bf16_t*)(p.ws + WS_WO), DM, DM, E); } break;
        case 12: if (PHEN(12)) ph_fin(cx, p); break;
        default: break;
        }
        }
    }
}

extern "C" void kernel_launch(void* const* d_in, const int* in_sizes, int n_in, void* d_out, int out_size, void* d_ws, size_t ws_size, hipStream_t stream) {
    static int grid = 0;
    if (grid == 0) {
        int dev = 0, cus = 0, per_cu = 0;
        (void)hipGetDevice(&dev);
        (void)hipDeviceGetAttribute(&cus, hipDeviceAttributeMultiprocessorCount, dev);
        (void)hipFuncSetAttribute((const void*)hybrid_block_fwd, hipFuncAttributeMaxDynamicSharedMemorySize, LDS_BYTES);
        if (hipOccupancyMaxActiveBlocksPerMultiprocessor(&per_cu, (const void*)hybrid_block_fwd, 512, LDS_BYTES) != hipSuccess || per_cu < 1) { (void)hipGetLastError(); per_cu = 1; }
        if (per_cu > 1) per_cu = 1;
        grid = cus * per_cu;
        if (ws_size < WS_SLOT + 8 * SLOT) fprintf(stderr, "kernel_launch: workspace too small: %zu\n", ws_size);
    }
    Params p{};
    p.x = (const float*)d_in[0]; p.norm_g = (const float*)d_in[1]; p.w_in = (const float*)d_in[2]; p.b_if = (const float*)d_in[3];
    p.conv_w = (const float*)d_in[4]; p.conv_b = (const float*)d_in[5]; p.mnorm_g = (const float*)d_in[6]; p.w_attn = (const float*)d_in[7];
    p.w_mlstm = (const float*)d_in[8]; p.w_out = (const float*)d_in[9]; p.final_g = (const float*)d_in[10];
    p.out = (float*)d_out; p.ws = (unsigned char*)d_ws; p.ph_lo = 0; p.ph_hi = NPHASE;
    void* args[] = {&p};
    hipError_t e = hipLaunchCooperativeKernel((const void*)hybrid_block_fwd, dim3(grid), dim3(512), args, LDS_BYTES, stream);
    if (e != hipSuccess) fprintf(stderr, "cooperative launch failed: %s (grid %d)\n", hipGetErrorString(e), grid);
}
```

```cpp
#include <hip/hip_runtime.h>
#include <hip/hip_cooperative_groups.h>
#include <cstdio>
#include <type_traits>
namespace cg = cooperative_groups;
namespace pg8 {
#define PG8_LAS __attribute__((address_space(3)))
typedef unsigned short bf16_t;
typedef short bf16x8 __attribute__((ext_vector_type(8)));
typedef float f32x4 __attribute__((ext_vector_type(4)));
typedef unsigned u32x4 __attribute__((ext_vector_type(4)));
constexpr int BM = 256, BK = 64, HALF = 128, HTB = HALF * BK * 2  , STAGE_BYTES = 8 * HTB, NXCD = 8, WGM = 8;

__host__ __device__ __forceinline__ int lds_byte(int r, int c) { const int st = (r >> 4) * 2 + (c >> 5), rr = r & 15, cc = c & 31, ob = rr * 64 + cc * 2; return st * 1024 + (ob ^ (((ob >> 9) & 1) << 5)); }
__host__ __device__ __forceinline__ void stage_rc(int b, int& R, int& C) { const int st = b / 1024, sb = b % 1024, swz = sb ^ (((sb >> 9) & 1) << 5); R = (st >> 1) * 16 + swz / 64; C = (st & 1) * 32 + (swz % 64) / 2; }
__host__ __device__ __forceinline__ int perm32(int rho) { const int n = rho >> 4, i = rho & 15; return 8 * (i >> 2) + 4 * n + (i & 3); }

struct Unit { int pm, pn; };
struct Gemm { const bf16_t* A; const bf16_t* Bt; int M, N, K; const bf16_t* A2; const bf16_t* Bt2; };

struct StaticOrder {
    int nM, nN, nwg, G, c;
    __host__ __device__ void init(int M, int N, int G_, int c_) { nM = M / BM; nN = N / BM; nwg = nM * nN; G = G_; c = c_; }
    __host__ __device__ bool next(int i, Unit& u) const {
        const long L = (long)i * G + c; if (L >= nwg) return false;
        int wgid = (int)L; { const int q = nwg / NXCD, r = nwg % NXCD, xcd = wgid % NXCD, off = wgid / NXCD; wgid = (xcd < r ? xcd * (q + 1) : r * (q + 1) + (xcd - r) * q) + off; }
        const int nig = WGM * nN, gid = wgid / nig, fm = gid * WGM, gsz = (nM - fm) < WGM ? (nM - fm) : WGM;
        u.pm = fm + ((wgid % nig) % gsz); u.pn = (wgid % nig) / gsz; return true;
    }
    __device__ __forceinline__ void a_ready(const Unit&) const {}
    __device__ __forceinline__ void done(const Unit&) const {}
};
typedef __bf16 bf16x2v_t __attribute__((ext_vector_type(2)));
typedef float f32x2v_t __attribute__((ext_vector_type(2)));
__device__ __forceinline__ unsigned cvt_pk_bf16(float lo, float hi) { const f32x2v_t f = {lo, hi}; const bf16x2v_t b = __builtin_convertvector(f, bf16x2v_t); return __builtin_bit_cast(unsigned, b); }
typedef float f32x2 __attribute__((ext_vector_type(2)));
template <class Epi, class Sched, bool STAMP = false>
__device__ __forceinline__ void gemm_phase(PG8_LAS unsigned char* lds, const Gemm g, const Sched& S, const Epi& E, unsigned long long* stamps, const int tid_in) {
    const int tid = tid_in, wid = __builtin_amdgcn_readfirstlane(tid >> 6), lane = tid & 63, wr = wid >> 2, wc = wid & 3, fr = lane & 15, fq = lane >> 4;
    const int K = g.K, nth = K / BK, nt = g.A2 ? 2 * nth : nth;
    int ts_lo = 0, ts_hi = 0, nts = 0; const unsigned long long rt_entry = STAMP ? (unsigned long long)wall_clock64() : 0ull;
#define PG8_STAMP() do { if (STAMP && wid == 0 && nts < 64) { const unsigned long long _c = (unsigned long long)clock64(); \
        ts_lo = (lane == nts) ? (int)(unsigned)_c : ts_lo; ts_hi = (lane == nts) ? (int)(unsigned)(_c >> 32) : ts_hi; ++nts; } } while (0)
    PG8_STAMP();
    unsigned voffA[2], voffB[2];
#pragma unroll
    for (int i = 0; i < 2; ++i) { int R, C; stage_rc(tid * 16 + i * 8192, R, C); const int Rb = Epi::PERM ? ((R & ~31) + perm32(R & 31)) : R;
        voffA[i] = (unsigned)(R * K + C) * 2u; voffB[i] = (unsigned)(Rb * K + C) * 2u; }
    const size_t kstep = (size_t)(BK * 2);
    const size_t hstep = (size_t)HALF * K * 2;
    const size_t tstep = 2 * hstep;
    const unsigned ldsw = (unsigned)wid * 1024u;
    const int aoff = lds_byte(wr * 64 + fr, fq * 8), boff = lds_byte(wc * 32 + fr, fq * 8);
#define PG8_SA(b, h) (((b) * 2 + (h)) * HTB)
#define PG8_SB(b, h) ((4 + (b) * 2 + (h)) * HTB)
#define PG8_STAGE(bufoff, gbase, voff) do { _Pragma("unroll") for (int _i = 0; _i < 2; ++_i) \
        __builtin_amdgcn_global_load_lds((const unsigned*)((const char*)(gbase) + (voff)[_i]), (PG8_LAS unsigned*)(lds + (bufoff) + ldsw + _i * 8192), 16, 0, 0); } while (0)
#define PG8_LDA(dst, b, h) do { _Pragma("unroll") for (int m = 0; m < 4; ++m) _Pragma("unroll") for (int k = 0; k < 2; ++k) dst[m][k] = *(const PG8_LAS bf16x8*)(lds + PG8_SA(b, h) + aoff + m * 2048 + k * 1024); } while (0)
#define PG8_LDB(dst, b, h) do { _Pragma("unroll") for (int n = 0; n < 2; ++n) _Pragma("unroll") for (int k = 0; k < 2; ++k) dst[n][k] = *(const PG8_LAS bf16x8*)(lds + PG8_SB(b, h) + boff + n * 2048 + k * 1024); } while (0)
#define PG8_MMA(ai, bj, At, Bt) do { __builtin_amdgcn_s_setprio(1); _Pragma("unroll") for (int m = 0; m < 4; ++m) _Pragma("unroll") for (int n = 0; n < 2; ++n) _Pragma("unroll") for (int k = 0; k < 2; ++k) \
        acc[ai][bj][m][n] = __builtin_amdgcn_mfma_f32_16x16x32_bf16(Bt[n][k], At[m][k], acc[ai][bj][m][n], 0, 0, 0); __builtin_amdgcn_s_setprio(0); } while (0)
#define PG8_WAIT_V(n) asm volatile("s_waitcnt vmcnt(" #n ")" ::: "memory")
#define PG8_WAIT_L(n) asm volatile("s_waitcnt lgkmcnt(" #n ")" ::: "memory")
#define PG8_BAR __builtin_amdgcn_s_barrier()
#define PG8_SCHED __builtin_amdgcn_sched_barrier(0)
    Unit cur, nxt; int ui = 0;
    if (!S.next(0, cur)) return;
    f32x4 acc[2][2][4][2];
#pragma unroll
    for (int a = 0; a < 2; ++a)
#pragma unroll
        for (int b = 0; b < 2; ++b)
#pragma unroll
            for (int m = 0; m < 4; ++m)
#pragma unroll
                for (int n = 0; n < 2; ++n) acc[a][b][m][n] = (f32x4){0.f, 0.f, 0.f, 0.f};
    bf16x8 At[4][2], B0[2][2], B1[2][2];
    const char* cA = (const char*)g.A + (size_t)cur.pm * tstep; const char* cB = (const char*)g.Bt + (size_t)cur.pn * tstep;
    const char* cA2 = g.A2 ? (const char*)g.A2 + (size_t)cur.pm * tstep : cA; const char* cB2 = g.Bt2 ? (const char*)g.Bt2 + (size_t)cur.pn * tstep : cB;
#define PG8_KT(u1, u2, tix) ((tix) < nth ? (u1) + (size_t)(tix) * kstep : (u2) + (size_t)((tix) - nth) * kstep)
    S.a_ready(cur);
    PG8_STAGE(PG8_SB(0, 0), cB, voffB); PG8_STAGE(PG8_SA(0, 0), cA, voffA); PG8_STAGE(PG8_SB(0, 1), cB + hstep, voffB); PG8_STAGE(PG8_SA(0, 1), cA + hstep, voffA);
    if (wr == 1) PG8_BAR;
    PG8_WAIT_V(4); PG8_BAR;
    PG8_STAGE(PG8_SB(1, 0), cB + kstep, voffB); PG8_STAGE(PG8_SA(1, 0), cA + kstep, voffA); PG8_STAGE(PG8_SB(1, 1), cB + hstep + kstep, voffB);
    PG8_WAIT_V(6); PG8_BAR;
    PG8_STAMP();
    for (;;) {
        const bool has_next = S.next(ui + 1, nxt);
        const char* nA = has_next ? (const char*)g.A + (size_t)nxt.pm * tstep : cA; const char* nB = has_next ? (const char*)g.Bt + (size_t)nxt.pn * tstep : cB;
        for (int t = 0; t < nt; t += 2) {
            const bool last = (t == nt - 2);
            if constexpr (Epi::HAS_MID) { if (t == nth) { PG8_SCHED; E.mid(acc, cur, wr, wc, fr, fq); PG8_SCHED; } }
            const char* a1 = PG8_KT(cA, cA2, t + 1);
            const char* a2 = last ? nA : PG8_KT(cA, cA2, t + 2); const char* b2 = last ? nB : PG8_KT(cB, cB2, t + 2);
            const char* a3 = last ? nA + kstep : PG8_KT(cA, cA2, t + 3); const char* b3 = last ? nB + kstep : PG8_KT(cB, cB2, t + 3);
            if (last && has_next) S.a_ready(nxt);
            PG8_LDB(B0, 0, 0); PG8_SCHED; PG8_LDA(At, 0, 0); PG8_STAGE(PG8_SA(1, 1), a1 + hstep, voffA);
            PG8_WAIT_L(8); PG8_BAR; PG8_WAIT_L(0); PG8_MMA(0, 0, At, B0); PG8_BAR; PG8_SCHED;
            PG8_LDB(B1, 0, 1); PG8_STAGE(PG8_SB(0, 0), b2, voffB);
            PG8_BAR; PG8_WAIT_L(0); PG8_MMA(0, 1, At, B1); PG8_BAR;
            PG8_LDA(At, 0, 1); PG8_STAGE(PG8_SA(0, 0), a2, voffA);
            PG8_BAR; PG8_WAIT_L(0); PG8_MMA(1, 0, At, B0); PG8_BAR; PG8_SCHED;
            PG8_STAGE(PG8_SB(0, 1), b2 + hstep, voffB);
            PG8_WAIT_V(6); PG8_BAR; PG8_MMA(1, 1, At, B1); PG8_BAR;
            PG8_LDB(B0, 1, 0); PG8_SCHED; PG8_LDA(At, 1, 0); PG8_STAGE(PG8_SA(0, 1), a2 + hstep, voffA);
            PG8_WAIT_L(8); PG8_BAR; PG8_WAIT_L(0); PG8_MMA(0, 0, At, B0); PG8_BAR; PG8_SCHED;
            PG8_LDB(B1, 1, 1); PG8_STAGE(PG8_SB(1, 0), b3, voffB);
            PG8_BAR; PG8_WAIT_L(0); PG8_MMA(0, 1, At, B1); PG8_BAR;
            PG8_LDA(At, 1, 1); PG8_STAGE(PG8_SA(1, 0), a3, voffA);
            PG8_BAR; PG8_WAIT_L(0); PG8_MMA(1, 0, At, B0); PG8_BAR; PG8_SCHED;
            PG8_STAGE(PG8_SB(1, 1), b3 + hstep, voffB);
            PG8_WAIT_V(6); PG8_BAR; PG8_MMA(1, 1, At, B1); PG8_BAR;
        }
        PG8_STAMP();
        if constexpr (!Epi::AFTER_DRAIN) { E(acc, cur, wr, wc, fr, fq); S.done(cur); }
        PG8_STAMP();
        if (!has_next) break;
#pragma unroll
        for (int a = 0; a < 2; ++a)
#pragma unroll
            for (int b = 0; b < 2; ++b)
#pragma unroll
                for (int m = 0; m < 4; ++m)
#pragma unroll
                    for (int n = 0; n < 2; ++n) acc[a][b][m][n] = (f32x4){0.f, 0.f, 0.f, 0.f};
        cur = nxt; cA = nA; cB = nB; ++ui;
        cA2 = g.A2 ? (const char*)g.A2 + (size_t)cur.pm * tstep : cA; cB2 = g.Bt2 ? (const char*)g.Bt2 + (size_t)cur.pn * tstep : cB;
    }
    PG8_WAIT_V(0);
    if (wr == 0) PG8_BAR;
    PG8_BAR;
    if constexpr (Epi::AFTER_DRAIN) { E.fused(acc, cur, wr, wc, fr, fq, lds, wid, lane); S.done(cur); }
    PG8_STAMP();
    if (STAMP && wid == 0) { stamps[lane] = lane < nts ? (((unsigned long long)(unsigned)ts_hi << 32) | (unsigned)ts_lo) : 0ull;
        if (lane == 62) stamps[62] = rt_entry; if (lane == 63) stamps[63] = (unsigned long long)wall_clock64(); }
#undef PG8_STAMP
#undef PG8_SA
#undef PG8_SB
#undef PG8_STAGE
#undef PG8_LDA
#undef PG8_LDB
#undef PG8_MMA
#undef PG8_WAIT_V
#undef PG8_WAIT_L
#undef PG8_BAR
#undef PG8_SCHED
#undef PG8_KT
}
}


using pg8::bf16_t; using pg8::bf16x8; using pg8::f32x4; using pg8::u32x4; using pg8::cvt_pk_bf16;
typedef short s16x4 __attribute__((ext_vector_type(4)));
typedef unsigned u32x2 __attribute__((ext_vector_type(2)));
#define LAS __attribute__((address_space(3)))
#define DI __device__ __forceinline__
#define XB_TMO      128
#define XB_XCNT(j)  (256  + 64 * (j))
#define XB_XSUB(j)  (1280 + 64 * (j))
#define XB_XGEN(j)  (2304 + 64 * (j))
#define XB_TOP      3328
#define XB_TOPGEN   3392
#define XCD_BAR_WORDS 3456
#define XB_SPIN_CAP (1u << 22)

__device__ __forceinline__ unsigned xb_ld(unsigned* p)              { return __hip_atomic_load(p, __ATOMIC_RELAXED, __HIP_MEMORY_SCOPE_AGENT); }
__device__ __forceinline__ unsigned xb_add(unsigned* p, unsigned v) { return __hip_atomic_fetch_add(p, v, __ATOMIC_RELAXED, __HIP_MEMORY_SCOPE_AGENT); }
__device__ __forceinline__ unsigned xb_xcc_id() { return (unsigned)__builtin_amdgcn_s_getreg((3 << 11) | 20) & 0xFu; }
#define XB_SPIN(cond, bar) do { unsigned _sp = 0; while (cond) { __builtin_amdgcn_s_sleep(1); \
    if ((++_sp & 255u) == 0u) { if (xb_ld(&(bar)[XB_TMO])) break; if (_sp > XB_SPIN_CAP) { atomicAdd(&(bar)[XB_TMO], 1u); break; } } } } while (0)

struct XcdBarrier {
    unsigned* bar; unsigned x;
    volatile LAS unsigned* st;
};

__device__ __forceinline__ XcdBarrier xcd_barrier_post(unsigned* bar, volatile LAS unsigned* st) {
    XcdBarrier b; b.bar = bar; b.x = xb_xcc_id(); b.st = st;
    if (threadIdx.x == 0) (void)xb_add(&bar[XB_XCNT(b.x)], 1u);
    return b;
}
__device__ __forceinline__ void xcd_barrier_complete(unsigned* bar, unsigned x, unsigned& nloc, unsigned& nx) {
    const unsigned G = gridDim.x * gridDim.y * gridDim.z;
    unsigned sum, cnt, mine, sp = 0u;
    for (;;) {
        sum = 0u; cnt = 0u; mine = 0u;
#pragma unroll
        for (unsigned j = 0; j < 16; ++j) { const unsigned c = xb_ld(&bar[XB_XCNT(j)]); sum += c; cnt += (c > 0u) ? 1u : 0u; mine = (j == x) ? c : mine; }
        if (sum == G) break;
        __builtin_amdgcn_s_sleep(1);
        if ((++sp & 255u) == 0u) { if (xb_ld(&bar[XB_TMO])) break; if (sp > XB_SPIN_CAP) { atomicAdd(&bar[XB_TMO], 1u); break; } }
    }
    nloc = mine > 0u ? mine : 1u; nx = cnt > 0u ? cnt : 1u;
}

__device__ __forceinline__ void xcd_barrier(const XcdBarrier& b) {
    asm volatile("s_waitcnt vmcnt(0)" ::: "memory");
    __syncthreads();
    if (threadIdx.x == 0) {
        unsigned* bar = b.bar;
        __builtin_amdgcn_s_waitcnt(0);
        unsigned nloc = b.st[0], nx = b.st[1];
        if (nloc == 0u) { xcd_barrier_complete(bar, b.x, nloc, nx); b.st[0] = nloc; b.st[1] = nx; }
        const unsigned old = xb_add(&bar[XB_XSUB(b.x)], 1u);
        const unsigned gen = old / nloc;
        if (old + 1u == (gen + 1u) * nloc) {
            __builtin_amdgcn_fence(__ATOMIC_RELEASE, "agent");
            asm volatile("s_waitcnt vmcnt(0)" ::: "memory");
            const unsigned og = xb_add(&bar[XB_TOP], 1u);
            const unsigned tg = og / nx;
            if (og + 1u == (tg + 1u) * nx) xb_add(&bar[XB_TOPGEN], 1u);
            else XB_SPIN(xb_ld(&bar[XB_TOPGEN]) == tg, bar);
            __builtin_amdgcn_fence(__ATOMIC_ACQUIRE, "agent");
            xb_add(&bar[XB_XGEN(b.x)], 1u);
            asm volatile("s_waitcnt vmcnt(0)" ::: "memory");
        } else {
            XB_SPIN(xb_ld(&bar[XB_XGEN(b.x)]) == gen, bar);
            __builtin_amdgcn_fence(__ATOMIC_ACQUIRE, "agent");
            asm volatile("s_waitcnt vmcnt(0)" ::: "memory");
        }
    }
    __syncthreads();
}


constexpr int M_TOK = 16384, DM = 2048, SEQ = 4096, INW = 20496;
constexpr size_t MiB = (size_t)1 << 20;
constexpr size_t WS_WINT = 0, WS_WA = 80 * MiB, WS_WM = 88 * MiB, WS_WO = 96 * MiB, WS_GATES = 104 * MiB, WS_LSE = 105 * MiB, WS_BAR = 108 * MiB, WS_SLOT = 112 * MiB, SLOT = 64 * MiB;
constexpr int LDS_BYTES = 143360 + 16;
constexpr int NPHASE = 13;

struct Params {
    const float *x, *norm_g, *w_in, *b_if, *conv_w, *conv_b, *mnorm_g, *w_attn, *w_mlstm, *w_out, *final_g;
    float* out; unsigned char* ws; int ph_lo, ph_hi;
};

struct Ctx { int tid, bid, nb; };
DI void lds_barrier() { asm volatile("s_waitcnt lgkmcnt(0)" ::: "memory"); __builtin_amdgcn_s_barrier(); asm volatile("" ::: "memory"); }
DI float bf_lo(unsigned u) { return __uint_as_float(u << 16); }
DI float bf_hi(unsigned u) { return __uint_as_float(u & 0xffff0000u); }
DI float bf1(bf16_t b) { return __uint_as_float(((unsigned)b) << 16); }
DI bf16_t f2bf(float f) { return (bf16_t)(cvt_pk_bf16(f, 0.f) & 0xffffu); }
DI float sigmoidf_(float z) { return __builtin_amdgcn_rcpf(1.f + __expf(-z)); }
DI float siluf_(float z) { return z * sigmoidf_(z); }
DI float wave_sum(float v) {
#pragma unroll
    for (int o = 1; o < 64; o <<= 1) v += __shfl_xor(v, o);
    return v;
}
DI bf16_t* slot(const Params& p, int i) { return (bf16_t*)(p.ws + WS_SLOT + (size_t)i * SLOT); }
DI f32x4 mfma16(bf16x8 a, bf16x8 b, f32x4 c) { return __builtin_amdgcn_mfma_f32_16x16x32_bf16(a, b, c, 0, 0, 0); }
DI bf16x8 tr8(LAS unsigned char* lo, LAS unsigned char* hi) {
    s16x4 a = __builtin_amdgcn_ds_read_tr16_b64_v4i16((LAS s16x4*)lo);
    s16x4 b = __builtin_amdgcn_ds_read_tr16_b64_v4i16((LAS s16x4*)hi);
    return __builtin_shufflevector(a, b, 0, 1, 2, 3, 4, 5, 6, 7);
}

template <bool NT> struct EpiSplitBf16T {
    static constexpr bool PERM = true, AFTER_DRAIN = false, HAS_MID = false;
    bf16_t* O; size_t seg_stride; bf16_t* O4; bf16_t* O5;
    DI void operator()(const f32x4 (&acc)[2][2][4][2], const pg8::Unit& u, int wr, int wc, int fr, int fq) const {
        const int row0 = u.pm * 256 + wr * 64 + fr; int colt = u.pn * 256; const int seg = colt >> 11; colt &= 2047;
        bf16_t* base = seg < 4 ? O + (size_t)seg * seg_stride : (seg == 4 ? O4 : O5); const int col0 = colt + wc * 32 + 8 * fq;
#pragma unroll
        for (int ai = 0; ai < 2; ++ai)
#pragma unroll
            for (int m = 0; m < 4; ++m) { bf16_t* rowp = base + (size_t)(row0 + ai * 128 + m * 16) * DM + col0;
#pragma unroll
                for (int bj = 0; bj < 2; ++bj) { const f32x4 v0 = acc[ai][bj][m][0], v1 = acc[ai][bj][m][1];
                    u32x4 w; w.x = cvt_pk_bf16(v0[0], v0[1]); w.y = cvt_pk_bf16(v0[2], v0[3]); w.z = cvt_pk_bf16(v1[0], v1[1]); w.w = cvt_pk_bf16(v1[2], v1[3]);
                    if (NT) __builtin_nontemporal_store(w, (u32x4*)(rowp + bj * 128)); else *(u32x4*)(rowp + bj * 128) = w; } }
    }
};
template <int MODE> struct EpiGate {
    static constexpr bool PERM = true, AFTER_DRAIN = false, HAS_MID = false;
    const bf16_t* gate; float* T; bf16_t* O;
    DI void operator()(const f32x4 (&acc)[2][2][4][2], const pg8::Unit& u, int wr, int wc, int fr, int fq) const {
        const int row0 = u.pm * 256 + wr * 64 + fr, col0 = u.pn * 256 + wc * 32 + 8 * fq;
#pragma unroll
        for (int ai = 0; ai < 2; ++ai)
#pragma unroll
            for (int m = 0; m < 4; ++m) { const size_t ro = (size_t)(row0 + ai * 128 + m * 16) * DM + col0;
#pragma unroll
                for (int bj = 0; bj < 2; ++bj) { const size_t o = ro + bj * 128;
                    const u32x4 gq = *(const u32x4*)(gate + o);
                    f32x4 v0 = acc[ai][bj][m][0], v1 = acc[ai][bj][m][1];
                    v0[0] *= sigmoidf_(bf_lo(gq.x)); v0[1] *= sigmoidf_(bf_hi(gq.x)); v0[2] *= sigmoidf_(bf_lo(gq.y)); v0[3] *= sigmoidf_(bf_hi(gq.y));
                    v1[0] *= sigmoidf_(bf_lo(gq.z)); v1[1] *= sigmoidf_(bf_hi(gq.z)); v1[2] *= sigmoidf_(bf_lo(gq.w)); v1[3] *= sigmoidf_(bf_hi(gq.w));
                    if (MODE == 0) { *(f32x4*)(T + o) = v0; *(f32x4*)(T + o + 4) = v1; }
                    else { v0 += *(const f32x4*)(T + o); v1 += *(const f32x4*)(T + o + 4);
                        u32x4 w; w.x = cvt_pk_bf16(v0[0], v0[1]); w.y = cvt_pk_bf16(v0[2], v0[3]); w.z = cvt_pk_bf16(v1[0], v1[1]); w.w = cvt_pk_bf16(v1[2], v1[3]);
                        *(u32x4*)(O + o) = w; } } }
    }
};
struct EpiResid {
    static constexpr bool PERM = false, AFTER_DRAIN = false, HAS_MID = false;
    const float* x; float* out;
    DI void operator()(const f32x4 (&acc)[2][2][4][2], const pg8::Unit& u, int wr, int wc, int fr, int fq) const {
        const int row0 = u.pm * 256 + wr * 64 + fr, col0 = u.pn * 256 + wc * 32 + 4 * fq;
#pragma unroll
        for (int ai = 0; ai < 2; ++ai)
#pragma unroll
            for (int m = 0; m < 4; ++m) { const size_t ro = (size_t)(row0 + ai * 128 + m * 16) * DM + col0;
#pragma unroll
                for (int bj = 0; bj < 2; ++bj)
#pragma unroll
                    for (int n = 0; n < 2; ++n) { const size_t o = ro + bj * 128 + n * 16; *(f32x4*)(out + o) = acc[ai][bj][m][n] + *(const f32x4*)(x + o); } }
    }
};
struct EpiMerge2 {
    static constexpr bool PERM = true, AFTER_DRAIN = false, HAS_MID = true;
    const bf16_t* ga; const bf16_t* gm; bf16_t* O;
    DI void mid(f32x4 (&acc)[2][2][4][2], const pg8::Unit& u, int wr, int wc, int fr_, int fq) const {
        int fr = fr_; asm volatile("" : "+v"(fr));
        const int row0 = u.pm * 256 + wr * 64 + fr, col0 = u.pn * 256 + wc * 32 + 8 * fq;
#pragma unroll
        for (int ai = 0; ai < 2; ++ai)
#pragma unroll
            for (int m = 0; m < 4; ++m) { const size_t ro = (size_t)(row0 + ai * 128 + m * 16) * DM + col0;
#pragma unroll
                for (int bj = 0; bj < 2; ++bj) { const size_t o = ro + bj * 128;
                    const u32x4 aq = *(const u32x4*)(ga + o), mq = *(const u32x4*)(gm + o);
#pragma unroll
                    for (int e = 0; e < 4; ++e) {
                        const float rl = (1.f + __expf(-bf_lo(mq[e]))) * __builtin_amdgcn_rcpf(1.f + __expf(-bf_lo(aq[e])));
                        const float rh = (1.f + __expf(-bf_hi(mq[e]))) * __builtin_amdgcn_rcpf(1.f + __expf(-bf_hi(aq[e])));
                        acc[ai][bj][m][e >> 1][(2 * e) & 3] *= rl; acc[ai][bj][m][e >> 1][((2 * e) & 3) + 1] *= rh; } }
                asm volatile("" ::: "memory"); }
    }
    DI void operator()(const f32x4 (&acc)[2][2][4][2], const pg8::Unit& u, int wr, int wc, int fr_, int fq) const {
        int fr = fr_; asm volatile("" : "+v"(fr));
        const int row0 = u.pm * 256 + wr * 64 + fr, col0 = u.pn * 256 + wc * 32 + 8 * fq;
#pragma unroll
        for (int ai = 0; ai < 2; ++ai)
#pragma unroll
            for (int m = 0; m < 4; ++m) { const size_t ro = (size_t)(row0 + ai * 128 + m * 16) * DM + col0;
#pragma unroll
                for (int bj = 0; bj < 2; ++bj) { const size_t o = ro + bj * 128;
                    const u32x4 gq = *(const u32x4*)(gm + o);
                    const f32x4 v0 = acc[ai][bj][m][0], v1 = acc[ai][bj][m][1];
                    u32x4 w; w.x = cvt_pk_bf16(v0[0] * sigmoidf_(bf_lo(gq.x)), v0[1] * sigmoidf_(bf_hi(gq.x))); w.y = cvt_pk_bf16(v0[2] * sigmoidf_(bf_lo(gq.y)), v0[3] * sigmoidf_(bf_hi(gq.y)));
                    w.z = cvt_pk_bf16(v1[0] * sigmoidf_(bf_lo(gq.z)), v1[1] * sigmoidf_(bf_hi(gq.z))); w.w = cvt_pk_bf16(v1[2] * sigmoidf_(bf_lo(gq.w)), v1[3] * sigmoidf_(bf_hi(gq.w)));
                    *(u32x4*)(O + o) = w; } }
    }
};
template <class Epi> DI void run_gemm(const Ctx cx, LAS unsigned char* lds, const bf16_t* A, const bf16_t* Bt, int N, int K, const Epi& E, const bf16_t* A2 = nullptr, const bf16_t* Bt2 = nullptr) {
    pg8::Gemm g; g.A = A; g.Bt = Bt; g.M = M_TOK; g.N = N; g.K = K; g.A2 = A2; g.Bt2 = Bt2;
    pg8::StaticOrder S; S.init(M_TOK, N, cx.nb, cx.bid);
    pg8::gemm_phase<Epi, pg8::StaticOrder, false>(lds, g, S, E, nullptr, cx.tid);
}

DI void transpose_item(const float* W, int ldw, int sc0, bf16_t* WT, int dr0, int kb, LAS float* scr, int lane) {
    const int k0 = 64 * kb;
    float t[64];
#pragma unroll
    for (int i = 0; i < 64; ++i) t[i] = __builtin_nontemporal_load(W + (size_t)(k0 + i) * ldw + sc0 + lane);
#pragma unroll
    for (int i = 0; i < 64; ++i) scr[i * 65 + lane] = t[i];
    asm volatile("s_waitcnt lgkmcnt(0)" ::: "memory");
    const int c = lane & 7;
#pragma unroll
    for (int j = 0; j < 8; ++j) { const int n = (lane >> 3) + 8 * j; const LAS float* s = scr + (8 * c) * 65 + n;
        u32x4 o; o.x = cvt_pk_bf16(s[0 * 65], s[1 * 65]); o.y = cvt_pk_bf16(s[2 * 65], s[3 * 65]); o.z = cvt_pk_bf16(s[4 * 65], s[5 * 65]); o.w = cvt_pk_bf16(s[6 * 65], s[7 * 65]);
        *(u32x4*)(WT + (size_t)(dr0 + n) * DM + k0 + 8 * c) = o; }
    asm volatile("s_waitcnt lgkmcnt(0)" ::: "memory");
}
DI float reduce16_cols(const f32x4 (&a)[4], int lane) {
    float t8[8];
#pragma unroll
    for (int c = 0; c < 8; ++c) { const float lo = a[c >> 2][c & 3], hi = a[(c + 8) >> 2][c & 3]; const bool up = (lane & 32) != 0;
        const float keep = up ? hi : lo, give = up ? lo : hi; t8[c] = keep + __shfl_xor(give, 32); }
    float t4[4];
#pragma unroll
    for (int c = 0; c < 4; ++c) { const bool up = (lane & 16) != 0; const float keep = up ? t8[c + 4] : t8[c], give = up ? t8[c] : t8[c + 4]; t4[c] = keep + __shfl_xor(give, 16); }
    float t2[2];
#pragma unroll
    for (int c = 0; c < 2; ++c) { const bool up = (lane & 8) != 0; const float keep = up ? t4[c + 2] : t4[c], give = up ? t4[c] : t4[c + 2]; t2[c] = keep + __shfl_xor(give, 8); }
    const bool up = (lane & 4) != 0; const float keep = up ? t2[1] : t2[0], give = up ? t2[0] : t2[1];
    float t1 = keep + __shfl_xor(give, 4);
    t1 += __shfl_xor(t1, 2); t1 += __shfl_xor(t1, 1);
    return t1;
}
DI void ph_prep(const Ctx cx, const Params& p, LAS unsigned char* lds) {
    const int tid = cx.tid, wave = tid >> 6, lane = tid & 63;
    const int gw = cx.bid * 8 + wave, NGW = cx.nb * 8;
    constexpr int PREP_RB = 5;
    const bool split = cx.nb == 256; const int xcd_ = cx.bid & 7, jb = cx.bid >> 3, grp8 = xcd_ * 4 + (jb >> 3), r8 = jb & 7;
    const bool do_rows = !split || r8 < PREP_RB, do_tr = !split || r8 >= PREP_RB;
    const int gwr = split ? (grp8 * PREP_RB + r8) * 8 + wave : gw, NGWR = split ? 32 * PREP_RB * 8 : NGW;
    const int NGWT = split ? 32 * (8 - PREP_RB) * 8 : NGW;
    bf16_t* hn = (bf16_t*)p.out;
    float* ig = (float*)(p.ws + WS_GATES); float* lf = ig + M_TOK * 8;
    if (do_rows) {
    f32x4 na[8], nb2[8];
#define PR_LOAD(pr_) do { const f32x4* xr_ = (const f32x4*)(p.x + (size_t)(2 * (pr_)) * DM) + lane; \
        _Pragma("unroll") for (int j = 0; j < 8; ++j) { na[j] = __builtin_nontemporal_load(xr_ + 64 * j); nb2[j] = __builtin_nontemporal_load(xr_ + 512 + 64 * j); } } while (0)
    if (gwr < M_TOK / 2) PR_LOAD(gwr);
#pragma unroll
    for (int i = 0; i < 16; ++i) { const int idx = tid + 512 * i, l = idx & 63, rest = idx >> 6, c4 = rest & 3, e = (rest >> 2) & 3, j = rest >> 4;
        *(LAS f32x4*)(lds + (size_t)idx * 16) = *(const f32x4*)(p.w_in + (size_t)(256 * j + 4 * l + e) * INW + 12288 + 4 * c4); }
    __syncthreads();
    for (int pr = gwr; pr < M_TOK / 2; pr += NGWR) {
        const int row = 2 * pr;
        f32x4 va[8], vb[8]; float sa = 0.f, sb = 0.f;
#pragma unroll
        for (int j = 0; j < 8; ++j) { va[j] = na[j]; vb[j] = nb2[j]; }
        const int prn = (pr + NGWR < M_TOK / 2) ? pr + NGWR : pr;
        const f32x4* xrn = (const f32x4*)(p.x + (size_t)(2 * prn) * DM) + lane;
#pragma unroll
        for (int j = 0; j < 8; ++j) { sa += (va[j].x * va[j].x + va[j].y * va[j].y) + (va[j].z * va[j].z + va[j].w * va[j].w);
            sb += (vb[j].x * vb[j].x + vb[j].y * vb[j].y) + (vb[j].z * vb[j].z + vb[j].w * vb[j].w); }
        sa = wave_sum(sa); sb = wave_sum(sb);
        const float rstda = rsqrtf(sa * (1.f / DM) + 1e-6f), rstdb = rsqrtf(sb * (1.f / DM) + 1e-6f);
        f32x4 acca[4], accb[4];
#pragma unroll
        for (int c = 0; c < 4; ++c) { acca[c] = (f32x4){0.f, 0.f, 0.f, 0.f}; accb[c] = (f32x4){0.f, 0.f, 0.f, 0.f}; }
#pragma unroll
        for (int j = 0; j < 8; ++j) {
            const f32x4 g4 = ((const f32x4*)p.norm_g)[64 * j + lane];
            const f32x4 ha = (va[j] * rstda) * g4, hb = (vb[j] * rstdb) * g4;
            na[j] = __builtin_nontemporal_load(xrn + 64 * j); nb2[j] = __builtin_nontemporal_load(xrn + 512 + 64 * j);
            u32x2 pk; pk.x = cvt_pk_bf16(ha.x, ha.y); pk.y = cvt_pk_bf16(ha.z, ha.w);
            *(u32x2*)(hn + (size_t)row * DM + 256 * j + 4 * lane) = pk;
            pk.x = cvt_pk_bf16(hb.x, hb.y); pk.y = cvt_pk_bf16(hb.z, hb.w);
            *(u32x2*)(hn + (size_t)(row + 1) * DM + 256 * j + 4 * lane) = pk;
#pragma unroll
            for (int e = 0; e < 4; ++e) {
#pragma unroll
                for (int c4 = 0; c4 < 4; ++c4) { const f32x4 w = *(const LAS f32x4*)(lds + (size_t)((((j * 4 + e) * 4 + c4) * 64) + lane) * 16);
                    acca[c4] += ha[e] * w; accb[c4] += hb[e] * w; }
                if (e & 1) asm volatile("" ::: "memory"); }
        }
        const float suma = reduce16_cols(acca, lane), sumb = reduce16_cols(accb, lane);
        if ((lane & 3) == 0) { const int col = ((lane >> 5) & 1) * 8 + ((lane >> 4) & 1) * 4 + ((lane >> 3) & 1) * 2 + ((lane >> 2) & 1);
            const float za = suma + p.b_if[col], zb = sumb + p.b_if[col];
            if (col < 8) { ig[(size_t)row * 8 + col] = za; ig[(size_t)(row + 1) * 8 + col] = zb; }
            else { lf[(size_t)row * 8 + col - 8] = fminf(za, 0.f) - log1pf(__expf(-fabsf(za))); lf[(size_t)(row + 1) * 8 + col - 8] = fminf(zb, 0.f) - log1pf(__expf(-fabsf(zb))); } }
    }
#undef PR_LOAD
    }
    __syncthreads();
    if (do_tr) {
    int lane_t = lane, wave_t = wave; asm volatile("" : "+v"(lane_t), "+v"(wave_t));
    LAS float* scr = (LAS float*)(lds + wave_t * 16640);
    constexpr int I_IN = 32 * 320, I_SQ = 32 * 32, NIT = I_IN + 3 * I_SQ;
    const int gwt = split ? (grp8 * (8 - PREP_RB) + (r8 - PREP_RB)) * 8 + wave_t : cx.bid * 8 + wave_t;
    for (int it = gwt; it < NIT; it += NGWT) {
        if (it < I_IN) { const int kb = it / 320, nb = it % 320, n0 = 64 * nb;
            transpose_item(p.w_in, INW, n0 < 12288 ? n0 : n0 + 16, (bf16_t*)(p.ws + WS_WINT), n0, kb, scr, lane_t); }
        else { int r = it - I_IN; const int which = r / I_SQ; r -= which * I_SQ; const int kb = r >> 5, nb = r & 31;
            const float* W = which == 0 ? p.w_attn : (which == 1 ? p.w_mlstm : p.w_out);
            bf16_t* WT = (bf16_t*)(p.ws + (which == 0 ? WS_WA : (which == 1 ? WS_WM : WS_WO)));
            transpose_item(W, DM, 64 * nb, WT, 64 * nb, kb, scr, lane_t); }
    }
    }
}

DI void ph_attn(const Ctx cx, const Params& p, LAS unsigned char* lds) {
    const bf16_t* Qg = slot(p, 0); const bf16_t* Kg = slot(p, 1); const bf16_t* Vg = slot(p, 2);
    float* lse = (float*)(p.ws + WS_LSE);
    const int tid = cx.tid, wave = __builtin_amdgcn_readfirstlane(tid >> 6), lane = tid & 63, fr = lane & 15, g = lane >> 4, q4 = fr >> 2, p4 = fr & 3;
    constexpr int RS = 272, VRS = 288;
    LAS unsigned char* Ks = lds; LAS unsigned char* Vs = lds + 256 * RS;
    const int i0 = wave * 16, w0 = i0 < 96 ? i0 : 96;
    u32x4 pk[8], pv[8]; bf16x8 qf[4];
    const bool fast = cx.nb == 256; const int xcd = cx.bid & 7, cuix = cx.bid >> 3, nit = fast ? 24 : (6144 - cx.bid + cx.nb - 1) / cx.nb;
#define ATT_ITEM(i) (fast ? (((((xcd * 8 + (i) / 3) * 3 + (i) % 3)) << 5) | ((cuix + (i)) & 31)) : cx.bid + (i) * cx.nb)
#define ATT_DECODE(itx) const int blk = (itx) & 31, rest = (itx) >> 5, pat = rest % 3, bh = rest / 3, h = bh & 15, b = bh >> 4; \
        const int sh = 2 * pat, r = 1 << sh, nblk = 32 >> sh, php = blk >> (5 - sh), n = blk & (nblk - 1); const size_t tok0 = (size_t)b * SEQ;
#define ATT_LOADKV(itx) do { ATT_DECODE(itx) \
        _Pragma("unroll") for (int i = 0; i < 8; ++i) { const int idx = tid + 512 * i, row = idx >> 4, ch = idx & 15; int uu = (n - 1) * 128 + row; uu = uu < 0 ? 0 : uu; \
            const size_t go = (tok0 + (size_t)uu * r + php) * DM + h * 128 + ch * 8; pk[i] = *(const u32x4*)(Kg + go); pv[i] = *(const u32x4*)(Vg + go); } } while (0)
#define ATT_LOADQ(itx) do { ATT_DECODE(itx) \
        const size_t tq = tok0 + (size_t)(n * 128 + i0 + fr) * r + php; const bf16_t* qp = Qg + tq * DM + h * 128 + 8 * g; \
        _Pragma("unroll") for (int ks = 0; ks < 4; ++ks) qf[ks] = *(const bf16x8*)(qp + 32 * ks); } while (0)
    if (nit > 0) { ATT_LOADKV(ATT_ITEM(0)); ATT_LOADQ(ATT_ITEM(0)); }
    for (int ii = 0; ii < nit; ++ii) {
        const int it = ATT_ITEM(ii), itn = ATT_ITEM(ii + 1);
        ATT_DECODE(it)
        lds_barrier();
#pragma unroll
        for (int i = 0; i < 8; ++i) { const int idx = tid + 512 * i, row = idx >> 4, ch = idx & 15;
            *(LAS u32x4*)(Ks + row * RS + ch * 16) = pk[i]; *(LAS u32x4*)(Vs + row * VRS + ch * 16) = pv[i]; }
        lds_barrier();
        if (ii + 1 < nit) ATT_LOADKV(itn);
        const int ktlo = n > 0 ? 0 : ((128 - w0) >> 4);
        const int koffr = (i0 - w0) >> 4;
        float mx = -INFINITY, den = 0.f; f32x4 oacc[8];
        {
            const float c1 = 0.08838834764831845f * 1.4426950408889634f, sl2 = exp2f(-0.5f * (float)(h + 1)) * (float)r * 1.4426950408889634f;
            int lv = lane; asm volatile("" : "+v"(lv));
            const int e0 = (lv & 15) - 4 * (lv >> 4);
            float ae[4];
#pragma unroll
            for (int jj = 0; jj < 4; ++jj) ae[jj] = -sl2 * (float)(e0 - jj);
            f32x4 sacc[10];
            LAS unsigned char* kbase = Ks + (w0 + 16 * koffr + fr) * RS + 16 * g;
            bf16x8 kfb[2][4];
#pragma unroll
            for (int ks = 0; ks < 4; ++ks) kfb[0][ks] = *(const LAS bf16x8*)(kbase + 64 * ks);
            sacc[9] = (f32x4){0.f, 0.f, 0.f, 0.f};
#pragma unroll
            for (int i = 0; i < 9; ++i) {
                if (i + 1 < 9) {
#pragma unroll
                    for (int ks = 0; ks < 4; ++ks) kfb[(i + 1) & 1][ks] = *(const LAS bf16x8*)(kbase + 16 * (i + 1) * RS + 64 * ks); }
                f32x4 a = (f32x4){0.f, 0.f, 0.f, 0.f};
#pragma unroll
                for (int ks = 0; ks < 4; ++ks) a = mfma16(kfb[i & 1][ks], qf[ks], a);
                const float tc = (koffr + i < ktlo) ? -INFINITY : sl2 * (float)(16 * i - 128);
#pragma unroll
                for (int jj = 0; jj < 4; ++jj) { float sv = fmaf(a[jj], c1, ae[jj] + tc);
                    if (i == 0) sv = (e0 - jj <= 0) ? sv : -INFINITY;
                    if (i == 8) sv = (e0 - jj >= 0) ? sv : -INFINITY;
                    a[jj] = sv; mx = fmaxf(mx, sv); }
                sacc[i] = a;
                asm volatile("" ::: "memory"); }
            if (ii + 1 < nit) ATT_LOADQ(itn);
            mx = fmaxf(mx, __shfl_xor(mx, 16)); mx = fmaxf(mx, __shfl_xor(mx, 32));
#pragma unroll
            for (int i = 0; i < 9; ++i)
#pragma unroll
                for (int jj = 0; jj < 4; ++jj) { const float pe = __builtin_amdgcn_exp2f(sacc[i][jj] - mx); den += pe; sacc[i][jj] = pe; }
            den += __shfl_xor(den, 16); den += __shfl_xor(den, 32);
#pragma unroll
            for (int dt = 0; dt < 8; ++dt) oacc[dt] = (f32x4){0.f, 0.f, 0.f, 0.f};
            LAS unsigned char* vbase = Vs + (w0 + 16 * koffr + 4 * g + q4) * VRS + 8 * p4;
            bf16x8 vfb[2][2]; bf16x8 pf;
#pragma unroll
            for (int d = 0; d < 2; ++d) vfb[0][d] = tr8(vbase + 32 * d, vbase + 32 * d + 16 * VRS);
#pragma unroll
            for (int u = 0; u < 20; ++u) { const int ks2 = u >> 2, qtr = u & 3;
                if (u + 1 < 20) { const int k2n = (u + 1) >> 2, qn = (u + 1) & 3; LAS unsigned char* vb = vbase + 32 * k2n * VRS;
#pragma unroll
                    for (int d = 0; d < 2; ++d) vfb[(u + 1) & 1][d] = tr8(vb + 32 * (2 * qn + d), vb + 32 * (2 * qn + d) + (k2n == 4 ? 0 : 16 * VRS)); }
                if (qtr == 0) { u32x4 pw; pw.x = cvt_pk_bf16(sacc[2 * ks2][0], sacc[2 * ks2][1]); pw.y = cvt_pk_bf16(sacc[2 * ks2][2], sacc[2 * ks2][3]);
                    pw.z = cvt_pk_bf16(sacc[2 * ks2 + 1][0], sacc[2 * ks2 + 1][1]); pw.w = cvt_pk_bf16(sacc[2 * ks2 + 1][2], sacc[2 * ks2 + 1][3]);
                    pf = __builtin_bit_cast(bf16x8, pw); }
#pragma unroll
                for (int d = 0; d < 2; ++d) oacc[2 * qtr + d] = mfma16(vfb[u & 1][d], pf, oacc[2 * qtr + d]);
                asm volatile("" ::: "memory"); }
        }
        const float inv = 1.f / den;
        const size_t tqo = tok0 + (size_t)(n * 128 + i0 + fr) * r + php;
        bf16_t* op = slot(p, 4 + pat) + tqo * DM + h * 128 + 4 * g;
#pragma unroll
        for (int dt = 0; dt < 8; ++dt) { u32x2 w; w.x = cvt_pk_bf16(oacc[dt][0] * inv, oacc[dt][1] * inv); w.y = cvt_pk_bf16(oacc[dt][2] * inv, oacc[dt][3] * inv);
            *(u32x2*)(op + 16 * dt) = w; }
        if (g == 0) lse[(size_t)pat * M_TOK * 16 + tqo * 16 + h] = (mx + __log2f(den)) * 0.6931471805599453f;
    }
#undef ATT_LOADKV
#undef ATT_ITEM
#undef ATT_LOADQ
#undef ATT_DECODE
}

DI void ph_comb(const Ctx cx, const Params& p) {
    const bf16_t* O0 = slot(p, 4); const bf16_t* O1 = slot(p, 5); const bf16_t* O2 = slot(p, 6); const bf16_t* Z = slot(p, 3);
    bf16_t* AG = slot(p, 7);
    const float* lse = (const float*)(p.ws + WS_LSE);
    const size_t nth = (size_t)cx.nb * 512, total = (size_t)M_TOK * 256;
    for (size_t idx0 = (size_t)cx.bid * 512 + cx.tid; idx0 < total; idx0 += 2 * nth) {
        u32x4 a0[2], a1[2], a2[2], z[2]; float l0[2], l1[2], l2[2]; size_t o[2]; bool ok[2];
#pragma unroll
        for (int q = 0; q < 2; ++q) { const size_t idx = idx0 + q * nth; ok[q] = idx < total; const size_t ix = ok[q] ? idx : idx0;
            const size_t m = ix >> 8; const int c8 = (int)(ix & 255), h = c8 >> 4; o[q] = m * DM + c8 * 8;
            l0[q] = lse[m * 16 + h]; l1[q] = lse[(size_t)M_TOK * 16 + m * 16 + h]; l2[q] = lse[(size_t)2 * M_TOK * 16 + m * 16 + h];
            a0[q] = __builtin_nontemporal_load((const u32x4*)(O0 + o[q])); a1[q] = __builtin_nontemporal_load((const u32x4*)(O1 + o[q])); a2[q] = __builtin_nontemporal_load((const u32x4*)(O2 + o[q])); z[q] = __builtin_nontemporal_load((const u32x4*)(Z + o[q])); }
#pragma unroll
        for (int q = 0; q < 2; ++q) {
            const float mxl = fmaxf(l0[q], fmaxf(l1[q], l2[q]));
            float w0 = __expf(l0[q] - mxl), w1 = __expf(l1[q] - mxl), w2 = __expf(l2[q] - mxl);
            const float inv = 1.f / (w0 + w1 + w2); w0 *= inv; w1 *= inv; w2 *= inv;
            u32x4 res;
#pragma unroll
            for (int e2 = 0; e2 < 4; ++e2) {
                const float lo = (w0 * bf_lo(a0[q][e2]) + w1 * bf_lo(a1[q][e2]) + w2 * bf_lo(a2[q][e2])) * siluf_(bf_lo(z[q][e2]));
                const float hi = (w0 * bf_hi(a0[q][e2]) + w1 * bf_hi(a1[q][e2]) + w2 * bf_hi(a2[q][e2])) * siluf_(bf_hi(z[q][e2]));
                res[e2] = cvt_pk_bf16(lo, hi); }
            if (ok[q]) *(u32x4*)(AG + o[q]) = res; }
    }
}

DI void ph_conv(const Ctx cx, const Params& p) {
    const bf16_t* U = slot(p, 0); bf16_t* QK = slot(p, 4);
    const size_t nth = (size_t)cx.nb * 512;
    for (size_t idx = (size_t)cx.bid * 512 + cx.tid; idx < (size_t)(M_TOK / 8) * 256; idx += nth) {
        const int c8 = (int)(idx & 255); const size_t t0 = (idx >> 8) * 8; const bool first = (t0 & (SEQ - 1)) == 0;
        float w[4][8], bias[8];
#pragma unroll
        for (int j = 0; j < 4; ++j) { const f32x4 a = *(const f32x4*)(p.conv_w + j * DM + c8 * 8), b2 = *(const f32x4*)(p.conv_w + j * DM + c8 * 8 + 4);
            w[j][0] = a.x; w[j][1] = a.y; w[j][2] = a.z; w[j][3] = a.w; w[j][4] = b2.x; w[j][5] = b2.y; w[j][6] = b2.z; w[j][7] = b2.w; }
        { const f32x4 a = *(const f32x4*)(p.conv_b + c8 * 8), b2 = *(const f32x4*)(p.conv_b + c8 * 8 + 4);
          bias[0] = a.x; bias[1] = a.y; bias[2] = a.z; bias[3] = a.w; bias[4] = b2.x; bias[5] = b2.y; bias[6] = b2.z; bias[7] = b2.w; }
        float u[11][8];
#pragma unroll
        for (int t = 0; t < 11; ++t) { u32x4 raw = (u32x4){0u, 0u, 0u, 0u};
            if (t >= 3 || !first) raw = *(const u32x4*)(U + (t0 + t - 3) * DM + c8 * 8);
#pragma unroll
            for (int e = 0; e < 4; ++e) { u[t][2 * e] = bf_lo(raw[e]); u[t][2 * e + 1] = bf_hi(raw[e]); } }
        const float osc = c8 >= 128 ? 0.08838834764831845f : 1.f;
#pragma unroll
        for (int t = 0; t < 8; ++t) { float y[8];
#pragma unroll
            for (int e = 0; e < 8; ++e) { float a = bias[e];
#pragma unroll
                for (int j = 0; j < 4; ++j) a += w[j][e] * u[t + j][e];
                y[e] = siluf_(a) * osc; }
            u32x4 res; res.x = cvt_pk_bf16(y[0], y[1]); res.y = cvt_pk_bf16(y[2], y[3]); res.z = cvt_pk_bf16(y[4], y[5]); res.w = cvt_pk_bf16(y[6], y[7]);
            *(u32x4*)(QK + (t0 + t) * DM + c8 * 8) = res; }
    }
}

DI void ph_mlstm(const Ctx cx, const Params& p, LAS unsigned char* lds) {
    const bf16_t* QK = slot(p, 4); const bf16_t* Vg = slot(p, 1); bf16_t* Hb = slot(p, 5);
    const float* igp = (const float*)(p.ws + WS_GATES); const float* lfp = igp + M_TOK * 8;
    const int tid = cx.tid, wave = __builtin_amdgcn_readfirstlane(tid >> 6), lane = tid & 63, fr = lane & 15, g = lane >> 4, q4 = fr >> 2, p4 = fr & 3;
    constexpr int RS = 272, VS = 112, BUF = 56576, O_Q = 0, O_K = 17408, O_V = 34816, O_C = 41984, O_G = 55040;
    constexpr int O_TB = 2 * BUF;
    const int tt = wave >> 1, wb = wave & 1;
    const u32x4 zero4 = (u32x4){0u, 0u, 0u, 0u};
    for (int item = cx.bid; item < 256; item += cx.nb) {
        int bhi = item >> 3, dvs = item & 7;
        if (cx.nb == 256) { bhi = (item & 7) * 4 + (item >> 6); dvs = (item >> 3) & 7; }
        const int b = bhi >> 3, h = bhi & 7;
        const size_t tok0 = (size_t)b * SEQ;
        __syncthreads();
        if (tid < 256) { const int bsel = tid >> 7, row = (tid >> 1) & 63, hf = tid & 1;
            *(LAS u32x4*)(lds + bsel * BUF + O_V + row * VS + 64 + hf * 16) = hf ? zero4 : (u32x4){0x3F80u, 0u, 0u, 0u}; }
        for (int i = tid; i < 816; i += 512) *(LAS u32x4*)(lds + O_C + i * 16) = zero4;
        f32x4 C[3];
#pragma unroll
        for (int ct = 0; ct < 3; ++ct) C[ct] = (f32x4){0.f, 0.f, 0.f, 0.f};
        float m_st = 0.f;
        struct PFSet { u32x4 q[2], k[2], v; };
        PFSet s0, s1; s0.v = zero4; s1.v = zero4;
        float gi = 0.f, gl = 0.f;
        const int prow = tid >> 4, pch = tid & 15;
#define ML_PREFETCH(S, cc) do { const size_t tb = tok0 + (size_t)(cc) * 64; \
            S.q[0] = *(const u32x4*)(QK + (tb + prow) * DM + h * 128 + pch * 8); S.q[1] = *(const u32x4*)(QK + (tb + prow + 32) * DM + h * 128 + pch * 8); \
            S.k[0] = *(const u32x4*)(QK + (tb + prow) * DM + 1024 + h * 128 + pch * 8); S.k[1] = *(const u32x4*)(QK + (tb + prow + 32) * DM + 1024 + h * 128 + pch * 8); \
            if (tid < 256) S.v = *(const u32x4*)(Vg + (tb + (tid >> 2)) * DM + h * 256 + dvs * 32 + (tid & 3) * 8); \
            } while (0)
#define ML_STORE(S, bp) do { LAS unsigned char* bp_ = (bp); \
            *(LAS u32x4*)(bp_ + O_Q + prow * RS + pch * 16) = S.q[0]; *(LAS u32x4*)(bp_ + O_Q + (prow + 32) * RS + pch * 16) = S.q[1]; \
            *(LAS u32x4*)(bp_ + O_K + prow * RS + pch * 16) = S.k[0]; *(LAS u32x4*)(bp_ + O_K + (prow + 32) * RS + pch * 16) = S.k[1]; \
            if (tid < 256) *(LAS u32x4*)(bp_ + O_V + (tid >> 2) * VS + (tid & 3) * 16) = S.v; } while (0)
#define ML_GLOAD(cc) do { const size_t tb = tok0 + (size_t)(cc) * 64; gi = igp[(tb + lane) * 8 + h]; gl = lfp[(tb + lane) * 8 + h]; } while (0)
#define ML_SCAN(cc) do { LAS float* tb_ = (LAS float*)(lds + O_TB) + ((cc) & 15) * 192; float bcs = gl; \
            _Pragma("unroll") for (int o = 1; o < 64; o <<= 1) { const float t_ = __shfl_up(bcs, o); if (lane >= o) bcs += t_; } \
            const float uu = gi - bcs; float cmx = uu; \
            _Pragma("unroll") for (int o = 1; o < 64; o <<= 1) { const float t_ = __shfl_up(cmx, o); if (lane >= o) cmx = fmaxf(cmx, t_); } \
            tb_[lane] = uu; tb_[64 + lane] = cmx; tb_[128 + lane] = bcs; } while (0)
#define ML_GATES(cc, bp) do { if (wave == 0) { const LAS float* tb_ = (const LAS float*)(lds + O_TB) + ((cc) & 15) * 192; LAS float* ga_ = (LAS float*)((bp) + O_G); \
            const float uu = tb_[lane], cmx = tb_[64 + lane], bcs = tb_[128 + lane]; \
            const float cm = fmaxf(m_st, cmx), mt = bcs + cm; \
            const float b_last = __int_as_float(__builtin_amdgcn_readlane(__float_as_int(bcs), 63)), cm63 = __int_as_float(__builtin_amdgcn_readlane(__float_as_int(cm), 63)); \
            ga_[lane] = uu; ga_[64 + lane] = cm; ga_[128 + lane] = __expf(m_st - cm); ga_[192 + lane] = __expf(-mt); ga_[256 + lane] = __expf(uu - cm63); \
            if (lane == 0) ga_[320] = __expf(m_st - cm63); \
            m_st = b_last + cm63; } } while (0)
        ML_GLOAD(wave); ML_SCAN(wave); ML_GLOAD(8 + wave); ML_SCAN(8 + wave);
        __syncthreads();
        ML_PREFETCH(s0, 0); ML_PREFETCH(s1, 1);
        ML_STORE(s0, lds); ML_GATES(0, lds);
        ML_PREFETCH(s0, 2);
        __syncthreads();
        for (int c2 = 0; c2 < 64; c2 += 2) {
#pragma unroll
          for (int hc = 0; hc < 2; ++hc) {
            const int c = c2 + hc;
            LAS unsigned char* cur = lds + hc * BUF; LAS unsigned char* nxt = lds + (hc ^ 1) * BUF;
            if (hc == 0) { if (c + 1 < 64) { ML_STORE(s1, nxt); ML_GATES(c + 1, nxt); if (c + 3 < 64) ML_PREFETCH(s1, c + 3); } }
            else { if (c + 1 < 64) { ML_STORE(s0, nxt); ML_GATES(c + 1, nxt); if (c + 3 < 64) ML_PREFETCH(s0, c + 3); } }
            if ((c & 7) == 0 && c + 16 + wave < 64) ML_GLOAD(c + 16 + wave);
            if ((c & 7) == 7 && c + 9 + wave < 64) ML_SCAN(c + 9 + wave);
            LAS unsigned char* qs = cur + O_Q; LAS unsigned char* ks = cur + O_K; LAS unsigned char* vs = cur + O_V; LAS unsigned char* cbs = cur + O_C;
            const LAS float* ga = (const LAS float*)(cur + O_G);
            const int t = 16 * tt + fr;
            const float cm_t = ga[64 + t], wi_t = ga[128 + t], emt_t = ga[192 + t];
            bf16x8 qf[4];
#pragma unroll
            for (int k4 = 0; k4 < 4; ++k4) qf[k4] = *(const LAS bf16x8*)(qs + t * RS + (32 * k4 + 8 * g) * 2);
            f32x4 sT[4];
#pragma unroll
            for (int st = 0; st < 4; ++st) { sT[st] = (f32x4){0.f, 0.f, 0.f, 0.f};
                if (st <= tt) {
#pragma unroll
                    for (int k4 = 0; k4 < 4; ++k4) { const bf16x8 kf = *(const LAS bf16x8*)(ks + (16 * st + fr) * RS + (32 * k4 + 8 * g) * 2); sT[st] = mfma16(kf, qf[k4], sT[st]); }
                    const f32x4 u4 = *(const LAS f32x4*)(ga + 16 * st + 4 * g);
#pragma unroll
                    for (int jj = 0; jj < 4; ++jj) { const int s = 16 * st + 4 * g + jj; sT[st][jj] *= (s <= t) ? __expf(u4[jj] - cm_t) : 0.f; } } }
            f32x4 nA = (f32x4){0.f, 0.f, 0.f, 0.f}, nD = nA, iA = nA, iD = nA;
#pragma unroll
            for (int k2 = 0; k2 < 2; ++k2) {
                if (2 * k2 <= tt) {
                    u32x4 sw; sw.x = cvt_pk_bf16(sT[2 * k2][0], sT[2 * k2][1]); sw.y = cvt_pk_bf16(sT[2 * k2][2], sT[2 * k2][3]);
                    sw.z = cvt_pk_bf16(sT[2 * k2 + 1][0], sT[2 * k2 + 1][1]); sw.w = cvt_pk_bf16(sT[2 * k2 + 1][2], sT[2 * k2 + 1][3]);
                    const bf16x8 scf = __builtin_bit_cast(bf16x8, sw);
                    LAS unsigned char* vb = vs + (32 * k2 + 4 * g + q4) * VS + 8 * p4;
                    const bf16x8 vA = tr8(vb + 32 * wb, vb + 32 * wb + 16 * VS);
                    const bf16x8 vD = tr8(vb + 64, vb + 64 + 16 * VS);
                    nA = mfma16(vA, scf, nA); nD = mfma16(vD, scf, nD); } }
#pragma unroll
            for (int k4 = 0; k4 < 4; ++k4) {
                const bf16x8 cA = *(const LAS bf16x8*)(cbs + (16 * wb + fr) * RS + (32 * k4 + 8 * g) * 2);
                const bf16x8 cD = *(const LAS bf16x8*)(cbs + (32 + fr) * RS + (32 * k4 + 8 * g) * 2);
                iA = mfma16(cA, qf[k4], iA); iD = mfma16(cD, qf[k4], iD); }
            {
                float den = wi_t * iD[0] + nD[0];
                den = __shfl(den, fr);
                const float dinv = 1.f / fmaxf(fabsf(den), emt_t);
                u32x2 w; w.x = cvt_pk_bf16((wi_t * iA[0] + nA[0]) * dinv, (wi_t * iA[1] + nA[1]) * dinv); w.y = cvt_pk_bf16((wi_t * iA[2] + nA[2]) * dinv, (wi_t * iA[3] + nA[3]) * dinv);
                *(u32x2*)(Hb + (tok0 + (size_t)c * 64 + t) * DM + h * 256 + dvs * 32 + 16 * wb + 4 * g) = w;
            }
            {
                const float w_old = ga[320];
#pragma unroll
                for (int ct = 0; ct < 3; ++ct) C[ct] *= w_old;
#pragma unroll
                for (int k2 = 0; k2 < 2; ++k2) {
                    LAS unsigned char* kb = ks + (32 * k2 + 8 * g + q4) * RS + (16 * wave + 4 * p4) * 2;
                    const bf16x8 kraw = tr8(kb, kb + 4 * RS);
                    const f32x4 w0 = *(const LAS f32x4*)(ga + 256 + 32 * k2 + 8 * g), w1 = *(const LAS f32x4*)(ga + 256 + 32 * k2 + 8 * g + 4);
                    u32x4 ka;
                    ka.x = cvt_pk_bf16(bf1((bf16_t)kraw[0]) * w0.x, bf1((bf16_t)kraw[1]) * w0.y); ka.y = cvt_pk_bf16(bf1((bf16_t)kraw[2]) * w0.z, bf1((bf16_t)kraw[3]) * w0.w);
                    ka.z = cvt_pk_bf16(bf1((bf16_t)kraw[4]) * w1.x, bf1((bf16_t)kraw[5]) * w1.y); ka.w = cvt_pk_bf16(bf1((bf16_t)kraw[6]) * w1.z, bf1((bf16_t)kraw[7]) * w1.w);
                    const bf16x8 kf = __builtin_bit_cast(bf16x8, ka);
                    LAS unsigned char* vb = vs + (32 * k2 + 8 * g + q4) * VS + 8 * p4;
#pragma unroll
                    for (int ct = 0; ct < 3; ++ct) { const bf16x8 vf = tr8(vb + 32 * ct, vb + 32 * ct + 4 * VS); C[ct] = mfma16(kf, vf, C[ct]); }
                }
#pragma unroll
                for (int ct = 0; ct < 3; ++ct) { u32x2 w; w.x = cvt_pk_bf16(C[ct][0], C[ct][1]); w.y = cvt_pk_bf16(C[ct][2], C[ct][3]);
                    *(LAS u32x2*)(nxt + O_C + (16 * ct + fr) * RS + (16 * wave + 4 * g) * 2) = w; }
            }
            lds_barrier();
          }
        }
#undef ML_PREFETCH
#undef ML_GLOAD
#undef ML_SCAN
#undef ML_GATES
#undef ML_STORE
    }
}

DI void ph_mnorm(const Ctx cx, const Params& p) {
    bf16_t* Hb = slot(p, 5); const bf16_t* MO = slot(p, 2); const bf16_t* MZ = slot(p, 3);
    const int wave = cx.tid >> 6, lane = cx.tid & 63;
    const int gw = cx.bid * 8 + wave, NGW = cx.nb * 8;
    u32x4 hn[4], on[4], zn[4];
#define MN_LOAD(r) do { _Pragma("unroll") for (int j = 0; j < 4; ++j) { const size_t o_ = (size_t)(r) * DM + 512 * j + 8 * lane; \
        hn[j] = __builtin_nontemporal_load((const u32x4*)(Hb + o_)); on[j] = __builtin_nontemporal_load((const u32x4*)(MO + o_)); zn[j] = __builtin_nontemporal_load((const u32x4*)(MZ + o_)); } } while (0)
    if (gw < M_TOK) MN_LOAD(gw);
    for (int row = gw; row < M_TOK; row += NGW) {
        u32x4 hq[4], oq[4], zq[4];
#pragma unroll
        for (int j = 0; j < 4; ++j) { hq[j] = hn[j]; oq[j] = on[j]; zq[j] = zn[j]; }
        if (row + NGW < M_TOK) MN_LOAD(row + NGW);
#pragma unroll
        for (int j = 0; j < 4; ++j) { const size_t o = (size_t)row * DM + 512 * j + 8 * lane;
            float cv[8]; float ss = 0.f;
#pragma unroll
            for (int e2 = 0; e2 < 4; ++e2) { cv[2 * e2] = sigmoidf_(bf_lo(oq[j][e2])) * bf_lo(hq[j][e2]); cv[2 * e2 + 1] = sigmoidf_(bf_hi(oq[j][e2])) * bf_hi(hq[j][e2]);
                ss += cv[2 * e2] * cv[2 * e2] + cv[2 * e2 + 1] * cv[2 * e2 + 1]; }
#pragma unroll
            for (int of = 1; of < 32; of <<= 1) ss += __shfl_xor(ss, of);
            const float rinv = rsqrtf(ss * (1.f / 256.f) + 1e-6f);
            const f32x4 g0 = *(const f32x4*)(p.mnorm_g + 512 * j + 8 * lane), g1 = *(const f32x4*)(p.mnorm_g + 512 * j + 8 * lane + 4);
            u32x4 res;
            res.x = cvt_pk_bf16(cv[0] * rinv * g0.x * siluf_(bf_lo(zq[j].x)), cv[1] * rinv * g0.y * siluf_(bf_hi(zq[j].x)));
            res.y = cvt_pk_bf16(cv[2] * rinv * g0.z * siluf_(bf_lo(zq[j].y)), cv[3] * rinv * g0.w * siluf_(bf_hi(zq[j].y)));
            res.z = cvt_pk_bf16(cv[4] * rinv * g1.x * siluf_(bf_lo(zq[j].z)), cv[5] * rinv * g1.y * siluf_(bf_hi(zq[j].z)));
            res.w = cvt_pk_bf16(cv[6] * rinv * g1.z * siluf_(bf_lo(zq[j].w)), cv[7] * rinv * g1.w * siluf_(bf_hi(zq[j].w)));
            *(u32x4*)(Hb + o) = res; }
    }
#undef MN_LOAD
}

DI void ph_fin(const Ctx cx, const Params& p) {
    const int wave = cx.tid >> 6, lane = cx.tid & 63;
    const int gw = cx.bid * 8 + wave, NGW = cx.nb * 8;
    const bf16_t* DL = slot(p, 3);
    f32x4 xn[8]; u32x2 dn[8];
#define FN_LOAD(r) do { const f32x4* xr_ = (const f32x4*)(p.x + (size_t)(r) * DM) + lane; const u32x2* dr_ = (const u32x2*)(DL + (size_t)(r) * DM) + lane; \
        _Pragma("unroll") for (int j = 0; j < 8; ++j) { xn[j] = __builtin_nontemporal_load(xr_ + 64 * j); dn[j] = __builtin_nontemporal_load(dr_ + 64 * j); } } while (0)
    if (gw < M_TOK) FN_LOAD(gw);
    for (int row = gw; row < M_TOK; row += NGW) {
        f32x4* orow = (f32x4*)(p.out + (size_t)row * DM) + lane;
        f32x4 v[8]; float s = 0.f;
#pragma unroll
        for (int j = 0; j < 8; ++j) { v[j] = xn[j]; v[j].x += bf_lo(dn[j].x); v[j].y += bf_hi(dn[j].x); v[j].z += bf_lo(dn[j].y); v[j].w += bf_hi(dn[j].y); }
        if (row + NGW < M_TOK) FN_LOAD(row + NGW);
#pragma unroll
        for (int j = 0; j < 8; ++j) s += (v[j].x * v[j].x + v[j].y * v[j].y) + (v[j].z * v[j].z + v[j].w * v[j].w);
        s = wave_sum(s);
        const float rstd = rsqrtf(s * (1.f / DM) + 1e-6f);
#pragma unroll
        for (int j = 0; j < 8; ++j) { const f32x4 g4 = ((const f32x4*)p.final_g)[64 * j + lane]; __builtin_nontemporal_store((v[j] * rstd) * g4, &orow[64 * j]); }
    }
#undef FN_LOAD
}

__global__ void __launch_bounds__(512, 2) hybrid_block_fwd(Params p) {
    extern __shared__ __attribute__((aligned(16))) unsigned char shm[];
    LAS unsigned char* lds = (LAS unsigned char*)shm;
    cg::grid_group grid = cg::this_grid();
    if (threadIdx.x < 4) ((volatile LAS unsigned*)(lds + 143360))[threadIdx.x] = 0u;
    __syncthreads();
    if (blockIdx.x == 0) { unsigned* bw = (unsigned*)(p.ws + WS_BAR); for (int i = threadIdx.x; i < XCD_BAR_WORDS; i += 512) bw[i] = 0u; }
    XcdBarrier xb; xb.bar = (unsigned*)(p.ws + WS_BAR); xb.x = 0u; xb.st = (volatile LAS unsigned*)(lds + 143360);
    for (int ph = p.ph_lo; ph < p.ph_hi; ++ph) {
        if (ph == 8 || ph == 10) continue;
        if (ph > p.ph_lo) { if (ph == p.ph_lo + 1) { grid.sync(); xb = xcd_barrier_post((unsigned*)(p.ws + WS_BAR), (volatile LAS unsigned*)(lds + 143360)); } else xcd_barrier(xb); }
#ifdef EXTRA_SYNCS
        if (ph == 3) { for (int i = 0; i < EXTRA_SYNCS; ++i) grid.sync(); }
#endif
#ifndef ONLY_PHASE
#define ONLY_PHASE -1
#endif
#ifndef REPEAT_PHASE
#define REPEAT_PHASE -1
#endif
        for (int rep = 0; rep < (ph == REPEAT_PHASE ? 2 : 1); ++rep) {
        if (rep) { if (ph == p.ph_lo) grid.sync(); else xcd_barrier(xb); }
        Ctx cx; cx.tid = threadIdx.x; cx.bid = blockIdx.x; cx.nb = gridDim.x;
        asm volatile("" : "+v"(cx.tid)); asm volatile("" : "+s"(cx.bid)); asm volatile("" : "+s"(cx.nb));
#define PHEN(k) (ONLY_PHASE < 0 || ONLY_PHASE == (k))
        switch (ph) {
        case 0: if (PHEN(0)) ph_prep(cx, p, lds); break;
        case 1: case 4: if (PHEN(1)) {
            const int grp = ph == 1 ? 0 : 1;
            EpiSplitBf16T<true> E; E.O = slot(p, 0); E.seg_stride = SLOT / 2; E.O4 = slot(p, 6); E.O5 = (bf16_t*)p.out + (size_t)32 * 1024 * 1024;
            run_gemm(cx, lds, (const bf16_t*)p.out, (const bf16_t*)(p.ws + WS_WINT) + (size_t)grp * 8192 * DM, grp == 1 ? 12288 : 8192, DM, E);
        } break;
        case 2: if (PHEN(2)) ph_attn(cx, p, lds); break;
        case 3: if (PHEN(3)) ph_comb(cx, p); break;
        case 5: if (PHEN(5)) ph_conv(cx, p); break;
        case 6: if (PHEN(6)) ph_mlstm(cx, p, lds); break;
        case 7: if (PHEN(7)) ph_mnorm(cx, p); break;
        case 9: if (PHEN(9)) { EpiMerge2 E; E.ga = slot(p, 6); E.gm = (const bf16_t*)p.out + (size_t)32 * 1024 * 1024; E.O = slot(p, 2);
            run_gemm(cx, lds, slot(p, 7), (const bf16_t*)(p.ws + WS_WA), DM, DM, E, slot(p, 5), (const bf16_t*)(p.ws + WS_WM)); } break;
        case 11: if (PHEN(11)) { EpiSplitBf16T<false> E; E.O = slot(p, 3); E.seg_stride = 0; E.O4 = nullptr; E.O5 = nullptr;
            run_gemm(cx, lds, slot(p, 2), (const bf16_t*)(p.ws + WS_WO), DM, DM, E); } break;
        case 12: if (PHEN(12)) ph_fin(cx, p); break;
        default: break;
        }
        }
    }
}

extern "C" void kernel_launch(void* const* d_in, const int* in_sizes, int n_in, void* d_out, int out_size, void* d_ws, size_t ws_size, hipStream_t stream) {
    static int grid = 0;
    if (grid == 0) {
        int dev = 0, cus = 0, per_cu = 0;
        (void)hipGetDevice(&dev);
        (void)hipDeviceGetAttribute(&cus, hipDeviceAttributeMultiprocessorCount, dev);
        (void)hipFuncSetAttribute((const void*)hybrid_block_fwd, hipFuncAttributeMaxDynamicSharedMemorySize, LDS_BYTES);
        if (hipOccupancyMaxActiveBlocksPerMultiprocessor(&per_cu, (const void*)hybrid_block_fwd, 512, LDS_BYTES) != hipSuccess || per_cu < 1) { (void)hipGetLastError(); per_cu = 1; }
        if (per_cu > 1) per_cu = 1;
        grid = cus * per_cu;
        if (ws_size < WS_SLOT + 8 * SLOT) fprintf(stderr, "kernel_launch: workspace too small: %zu\n", ws_size);
    }
    Params p{};
    p.x = (const float*)d_in[0]; p.norm_g = (const float*)d_in[1]; p.w_in = (const float*)d_in[2]; p.b_if = (const float*)d_in[3];
    p.conv_w = (const float*)d_in[4]; p.conv_b = (const float*)d_in[5]; p.mnorm_g = (const float*)d_in[6]; p.w_attn = (const float*)d_in[7];
    p.w_mlstm = (const float*)d_in[8]; p.w_out = (const float*)d_in[9]; p.final_g = (const float*)d_in[10];
    p.out = (float*)d_out; p.ws = (unsigned char*)d_ws; p.ph_lo = 0; p.ph_hi = NPHASE;
    void* args[] = {&p};
    hipError_t e = hipLaunchCooperativeKernel((const void*)hybrid_block_fwd, dim3(grid), dim3(512), args, LDS_BYTES, stream);
    if (e != hipSuccess) fprintf(stderr, "cooperative launch failed: %s (grid %d)\n", hipGetErrorString(e), grid);
}
```
